# Optimizing an MI355X kernel written in HIP

```python
import jax, jax.numpy as jnp
from jax import lax
import numpy as np

D_MODEL = 2048
BATCH = 4
SEQ = 4096
DEPTH = 1

GRID_W = 64
CTX_LEN = 256
N_MOD = 6
EPS = 1e-6
POOL_WINDOWS = (2, 4, 8, 16)
POOL_GROUPS = 4
POOL_GROUP_DIM = D_MODEL // 8
POOL_DIM = POOL_GROUPS * POOL_GROUP_DIM
MLA_HEADS = D_MODEL // 128
Q_LORA = D_MODEL // 4
KV_LORA = D_MODEL // 4
QK_NOPE = 128
QK_ROPE = 64
V_HEAD = 128
QK_HEAD = QK_NOPE + QK_ROPE
ROPE_FREQS = QK_ROPE // 4
ROPE_BASE = 10000.0
Q_BLOCK = 128
ATTN_SCALE = QK_HEAD ** -0.5
N_BRANCH = 2
IN_DIM = POOL_DIM + Q_LORA + KV_LORA + QK_ROPE + N_BRANCH * D_MODEL
SPLITS = (POOL_DIM, POOL_DIM + Q_LORA, POOL_DIM + Q_LORA + KV_LORA, POOL_DIM + Q_LORA + KV_LORA + QK_ROPE)
N_GROUPS = 4
EXPERTS_PER_GROUP = 8
N_EXPERTS = N_GROUPS * EXPERTS_PER_GROUP
TOP_K = 2
D_EXPERT = D_MODEL // 4

kernel_name = "hybrid_pool_mla_hmoe_diffusion_block"


def rms_norm(x, g):
    xf = x.astype(jnp.float32)
    y = xf * lax.rsqrt(jnp.mean(xf * xf, axis=-1, keepdims=True) + EPS)
    return (y * g.astype(jnp.float32)).astype(x.dtype)


def modulate(x, shift, scale):
    return x * (1 + scale) + shift


def axial_rope_tables(L):
    rows = L // GRID_W
    row = jnp.repeat(jnp.arange(rows, dtype=jnp.float32), GRID_W)
    col = jnp.tile(jnp.arange(GRID_W, dtype=jnp.float32), rows)
    freqs = 1.0 / (ROPE_BASE ** (jnp.arange(ROPE_FREQS, dtype=jnp.float32) / ROPE_FREQS))
    ang_r = row[:, None] * freqs[None, :]
    ang_c = col[:, None] * freqs[None, :]
    ang = jnp.concatenate([ang_r, ang_r, ang_c, ang_c], axis=-1)
    return jnp.cos(ang), jnp.sin(ang)


def apply_rope(x, cos, sin):
    xs = x.reshape(x.shape[:-1] + (2, 2, ROPE_FREQS))
    rot = jnp.stack([-xs[..., 1, :], xs[..., 0, :]], axis=-2).reshape(x.shape)
    return (x * cos + rot * sin).astype(x.dtype)


def pool_diff(u, window):
    B, L, C = u.shape
    cs = jnp.concatenate([jnp.zeros((B, 1, C), jnp.float32), jnp.cumsum(u.astype(jnp.float32), axis=1)], axis=1)
    t = jnp.arange(L)
    hi = jnp.minimum(t + window // 2, L)
    lo = jnp.maximum(t - window // 2, 0)
    cnt = (hi - lo).astype(jnp.float32)[None, :, None]
    mean = (cs[:, hi] - cs[:, lo]) / cnt
    return mean.astype(u.dtype) - u


def pool_branch(u, pool_w, pool_scale):
    B, L, _ = u.shape
    ug = u.reshape(B, L, POOL_GROUPS, POOL_GROUP_DIM)
    pooled = jnp.stack([pool_diff(ug[:, :, g], w) for g, w in enumerate(POOL_WINDOWS)], axis=2)
    mixed = jnp.einsum('blgc,gcd->blgd', pooled, pool_w)
    return mixed.reshape(B, L, POOL_DIM) * pool_scale


def mla_queries(q_c, q_norm, w_uq, cos, sin):
    B, L, _ = q_c.shape
    q = (rms_norm(q_c, q_norm) @ w_uq).reshape(B, L, MLA_HEADS, QK_HEAD)
    if cos is not None:
        q = jnp.concatenate([q[..., :QK_NOPE], apply_rope(q[..., QK_NOPE:], cos[:, None, :], sin[:, None, :])], axis=-1)
    return q


def mla_keys_values(kv_c, k_r, kv_norm, w_ukv, cos, sin):
    B, L, _ = kv_c.shape
    kv = (rms_norm(kv_c, kv_norm) @ w_ukv).reshape(B, L, MLA_HEADS, QK_NOPE + V_HEAD)
    k_nope, v = kv[..., :QK_NOPE], kv[..., QK_NOPE:]
    if cos is not None:
        k_r = apply_rope(k_r, cos, sin)
    k = jnp.concatenate([k_nope, jnp.broadcast_to(k_r[:, :, None, :], (B, L, MLA_HEADS, QK_ROPE))], axis=-1)
    return k, v


def attend(q, k, v):
    s = jnp.einsum('bqhd,bkhd->bhqk', q, k).astype(jnp.float32) * ATTN_SCALE
    p = jax.nn.softmax(s, axis=-1).astype(v.dtype)
    return jnp.einsum('bhqk,bkhd->bqhd', p, v)


def latent_attention(q, k_lat, v_lat, k_ctx, v_ctx):
    k = jnp.concatenate([k_lat, k_ctx], axis=1)
    v = jnp.concatenate([v_lat, v_ctx], axis=1)
    B, L, H, Dq = q.shape
    nb = L // Q_BLOCK
    qb = q.reshape(B, nb, Q_BLOCK, H, Dq).transpose(1, 0, 2, 3, 4)
    o = lax.map(lambda qi: attend(qi, k, v), qb)
    return o.transpose(1, 0, 2, 3, 4).reshape(B, L, H * V_HEAD)


def merge_branches(pool_in, attn_out, gates, pool_w, pool_scale, w_pool_up, w_attn_o, w_out):
    pool_out = pool_branch(pool_in, pool_w, pool_scale)
    g_pool, g_attn = jnp.split(gates, N_BRANCH, axis=-1)
    merged = jax.nn.sigmoid(g_pool) * (pool_out @ w_pool_up) + jax.nn.sigmoid(g_attn) * (attn_out @ w_attn_o)
    return merged @ w_out


def hier_moe(h, wg, bg, we, be, w_gate, w_up, w_down):
    B, L, D = h.shape
    t = h.reshape(-1, D)
    pg = jax.nn.softmax((t @ wg + bg).astype(jnp.float32), axis=-1)
    pg_top, g_idx = lax.top_k(pg, 1)
    le = (t @ we + be).astype(jnp.float32).reshape(-1, N_GROUPS, EXPERTS_PER_GROUP)
    le_sel = jnp.einsum('tg,tge->te', jax.nn.one_hot(g_idx[:, 0], N_GROUPS, dtype=jnp.float32), le)
    pe = jax.nn.softmax(le_sel, axis=-1)
    pe_top, e_idx = lax.top_k(pe, TOP_K)
    w = pg_top * pe_top / jnp.sum(pe_top, axis=-1, keepdims=True)
    eid = g_idx * EXPERTS_PER_GROUP + e_idx
    combine = jnp.einsum('tk,tke->te', w, jax.nn.one_hot(eid, N_EXPERTS, dtype=jnp.float32)).astype(h.dtype)
    y = jnp.zeros_like(t)
    for e in range(N_EXPERTS):
        y = y + combine[:, e:e + 1] * ((jax.nn.silu(t @ w_gate[e]) * (t @ w_up[e])) @ w_down[e])
    return y.reshape(B, L, D)


def setup_inputs(seed: int = 0) -> dict:
    key = jax.random.key(seed)
    ks = jax.random.split(key, 32)
    f = jnp.float32

    def nrm(k, shape, scale):
        return jax.random.normal(k, shape, f) * scale

    def gain(k, shape):
        return 1.0 + 0.02 * jax.random.normal(k, shape, f)

    Dp = DEPTH
    return {
        "x": nrm(ks[0], (BATCH, SEQ, D_MODEL), 1.0),
        "c": nrm(ks[1], (BATCH, D_MODEL), 1.0),
        "ctx": nrm(ks[2], (BATCH, CTX_LEN, D_MODEL), 1.0),
        "c_ctx": nrm(ks[3], (D_MODEL,), 1.0),
        "w_mod": nrm(ks[4], (Dp, D_MODEL, N_MOD * D_MODEL), 0.5 * D_MODEL ** -0.5),
        "b_mod": nrm(ks[5], (Dp, N_MOD * D_MODEL), 0.02),
        "norm_pre_mix": gain(ks[6], (Dp, D_MODEL)),
        "norm_post_mix": gain(ks[7], (Dp, D_MODEL)),
        "norm_pre_ffn": gain(ks[8], (Dp, D_MODEL)),
        "norm_post_ffn": gain(ks[9], (Dp, D_MODEL)),
        "w_in": nrm(ks[10], (Dp, D_MODEL, IN_DIM), D_MODEL ** -0.5),
        "pool_w": nrm(ks[11], (Dp, POOL_GROUPS, POOL_GROUP_DIM, POOL_GROUP_DIM), POOL_GROUP_DIM ** -0.5),
        "pool_scale": 1.0 + 0.1 * jax.random.normal(ks[12], (Dp, POOL_DIM), f),
        "w_pool_up": nrm(ks[13], (Dp, POOL_DIM, D_MODEL), POOL_DIM ** -0.5),
        "q_norm": gain(ks[14], (Dp, Q_LORA)),
        "w_uq": nrm(ks[15], (Dp, Q_LORA, MLA_HEADS * QK_HEAD), Q_LORA ** -0.5),
        "kv_norm": gain(ks[16], (Dp, KV_LORA)),
        "w_ukv": nrm(ks[17], (Dp, KV_LORA, MLA_HEADS * (QK_NOPE + V_HEAD)), KV_LORA ** -0.5),
        "w_attn_o": nrm(ks[18], (Dp, MLA_HEADS * V_HEAD, D_MODEL), (MLA_HEADS * V_HEAD) ** -0.5),
        "w_out": nrm(ks[19], (Dp, D_MODEL, D_MODEL), D_MODEL ** -0.5),
        "router_group_w": nrm(ks[20], (Dp, D_MODEL, N_GROUPS), D_MODEL ** -0.5),
        "router_group_b": nrm(ks[21], (Dp, N_GROUPS), 0.01),
        "router_expert_w": nrm(ks[22], (Dp, D_MODEL, N_EXPERTS), D_MODEL ** -0.5),
        "router_expert_b": nrm(ks[23], (Dp, N_EXPERTS), 0.01),
        "w_gate": nrm(ks[24], (Dp, N_EXPERTS, D_MODEL, D_EXPERT), D_MODEL ** -0.5),
        "w_up": nrm(ks[25], (Dp, N_EXPERTS, D_MODEL, D_EXPERT), D_MODEL ** -0.5),
        "w_down": nrm(ks[26], (Dp, N_EXPERTS, D_EXPERT, D_MODEL), D_EXPERT ** -0.5),
    }


def reference(x, c, ctx, c_ctx, w_mod, b_mod, norm_pre_mix, norm_post_mix, norm_pre_ffn, norm_post_ffn,
              w_in, pool_w, pool_scale, w_pool_up, q_norm, w_uq, kv_norm, w_ukv, w_attn_o, w_out,
              router_group_w, router_group_b, router_expert_w, router_expert_b, w_gate, w_up, w_down):
    L = x.shape[1]
    cos, sin = axial_rope_tables(L)
    ctx_s = ctx
    for i in range(DEPTH):
        last = i + 1 == DEPTH
        mod_x = (jax.nn.silu(c) @ w_mod[i] + b_mod[i])[:, None, :]
        mod_c = (jax.nn.silu(c_ctx) @ w_mod[i] + b_mod[i])[None, None, :]
        sh1, sc1, g1, sh2, sc2, g2 = jnp.split(mod_x, N_MOD, axis=-1)
        sh1c, sc1c, g1c, sh2c, sc2c, g2c = jnp.split(mod_c, N_MOD, axis=-1)

        h_x = modulate(rms_norm(x, norm_pre_mix[i]), sh1, sc1)
        h_c = modulate(rms_norm(ctx_s, norm_pre_mix[i]), sh1c, sc1c)
        pool_x, qc_x, kvc_x, kr_x, gate_x = jnp.split(h_x @ w_in[i], SPLITS, axis=-1)
        pool_c, qc_c, kvc_c, kr_c, gate_c = jnp.split(h_c @ w_in[i], SPLITS, axis=-1)
        k_c, v_c = mla_keys_values(kvc_c, kr_c, kv_norm[i], w_ukv[i], None, None)
        q_x = mla_queries(qc_x, q_norm[i], w_uq[i], cos, sin)
        k_x, v_x = mla_keys_values(kvc_x, kr_x, kv_norm[i], w_ukv[i], cos, sin)
        attn_x = latent_attention(q_x, k_x, v_x, k_c, v_c)
        y_x = merge_branches(pool_x, attn_x, gate_x, pool_w[i], pool_scale[i], w_pool_up[i], w_attn_o[i], w_out[i])
        x = x + g1 * rms_norm(y_x, norm_post_mix[i])
        if not last:
            q_c = mla_queries(qc_c, q_norm[i], w_uq[i], None, None)
            attn_c = attend(q_c, k_c, v_c).reshape(ctx_s.shape[0], ctx_s.shape[1], MLA_HEADS * V_HEAD)
            y_c = merge_branches(pool_c, attn_c, gate_c, pool_w[i], pool_scale[i], w_pool_up[i], w_attn_o[i], w_out[i])
            ctx_s = ctx_s + g1c * rms_norm(y_c, norm_post_mix[i])

        h2 = modulate(rms_norm(x, norm_pre_ffn[i]), sh2, sc2)
        y2 = hier_moe(h2, router_group_w[i], router_group_b[i], router_expert_w[i], router_expert_b[i],
                      w_gate[i], w_up[i], w_down[i])
        x = x + g2 * rms_norm(y2, norm_post_ffn[i])
        if not last:
            h2c = modulate(rms_norm(ctx_s, norm_pre_ffn[i]), sh2c, sc2c)
            y2c = hier_moe(h2c, router_group_w[i], router_group_b[i], router_expert_w[i], router_expert_b[i],
                           w_gate[i], w_up[i], w_down[i])
            ctx_s = ctx_s + g2c * rms_norm(y2c, norm_post_ffn[i])
    return x
```

```cpp
#include <hip/hip_runtime.h>
#include <cstdio>
#include <cstdint>

#ifndef MK_PER_PHASE
#define MK_PER_PHASE 0
#endif

#define GAS __attribute__((address_space(1)))
#define LAS __attribute__((address_space(3)))
typedef unsigned short bf16_t;
typedef short bf16x8 __attribute__((ext_vector_type(8)));
typedef short s16x4 __attribute__((ext_vector_type(4)));
typedef float f32x2 __attribute__((ext_vector_type(2)));
typedef float f32x4 __attribute__((ext_vector_type(4)));
typedef float f32x16 __attribute__((ext_vector_type(16)));
typedef unsigned u32x2 __attribute__((ext_vector_type(2)));
typedef unsigned u32x4 __attribute__((ext_vector_type(4)));
typedef int i32x4 __attribute__((ext_vector_type(4)));
typedef int i32x8 __attribute__((ext_vector_type(8)));

constexpr int T = 16384, TC = 1024, TA = T + TC, DM = 2048, NMODC = 12288;
constexpr int N1 = 6400;
constexpr int NQ = 3072, NKV = 4096;
constexpr int NEXP = 32, DE = 512;
constexpr int HS_ROWS = 40960;
constexpr float EPS = 1e-6f;

constexpr size_t MiB = 1ull << 20, KiB = 1024;
constexpr size_t WS_CTL = 0, CTL_ZERO_BYTES = 64 * KiB;
constexpr int CW_TMO = 0, CW_BAR = 4096, CW_CNT = 8192;
constexpr size_t WS_MOD = 1 * MiB, WS_CS = 1 * MiB + 512 * KiB, WS_SSQQ = 2 * MiB, WS_SSQKV = 3 * MiB;
constexpr size_t WS_TI = 6 * MiB, WS_TW = 6 * MiB + 256 * KiB, WS_BLKB = 6 * MiB + 512 * KiB, WS_ROWMAP = 6 * MiB + 768 * KiB;
constexpr size_t WS_ROWMAP2 = 100 * MiB; constexpr int RM_CAP = 16384;
constexpr size_t WS_WRH = 7 * MiB, WS_WRL = 7 * MiB + 256 * KiB, WS_PW = 7 * MiB + 512 * KiB;
constexpr size_t WS_W1T = 8 * MiB, WS_WQT = 33 * MiB, WS_WKVT = 36 * MiB, WS_BPT = 40 * MiB, WS_WPPT = 44 * MiB, WS_WOT = 48 * MiB, WS_WOUTT = 56 * MiB;
constexpr size_t WS_H = 64 * MiB, WS_ATT = 64 * MiB, WS_H2 = 64 * MiB;
constexpr size_t WS_POOLIN = 132 * MiB, WS_QC = 164 * MiB, WS_KVC = 180 * MiB, WS_KR = 197 * MiB, WS_GATES = 200 * MiB;
constexpr size_t WS_Q = 328 * MiB, WS_KV = 424 * MiB, WS_POOLED = 560 * MiB, WS_T1 = 592 * MiB, WS_YX = 592 * MiB;
constexpr size_t WS_MERGED = 132 * MiB;
constexpr size_t WS_X1B = 132 * MiB;
constexpr size_t WS_VB = WS_KV + 34 * MiB;
constexpr size_t WS_KR2 = 656 * MiB;
constexpr size_t WS_WGU = 328 * MiB, WS_WD = 456 * MiB, WS_ACT = 520 * MiB, WS_Y2 = 560 * MiB;
constexpr size_t WS_END = 688 * MiB;

constexpr int RING_BYTES = 147456, MISC_OFF = RING_BYTES, LDS_BYTES = 163840;

#define LDS_WAIT() asm volatile("s_waitcnt lgkmcnt(0)" ::: "memory")
#define VM_WAIT() asm volatile("s_waitcnt vmcnt(0)" ::: "memory")
#define RLX_AGENT __ATOMIC_RELAXED, __HIP_MEMORY_SCOPE_AGENT
__device__ __forceinline__ unsigned f2bf(float f) { unsigned u = __builtin_bit_cast(unsigned, f); return (u + 0x7fffu + ((u >> 16) & 1u)) >> 16; }
__device__ __forceinline__ unsigned pk2(float lo, float hi) { return f2bf(lo) | (f2bf(hi) << 16); }
__device__ __forceinline__ float bflo(unsigned w) { return __uint_as_float(w << 16); }
__device__ __forceinline__ float bfhi(unsigned w) { return __uint_as_float(w & 0xffff0000u); }
typedef __bf16 bf16x2_t __attribute__((ext_vector_type(2)));
__device__ __forceinline__ unsigned cvt_pk_bf16(float lo, float hi) { const f32x2 v = {lo, hi}; return __builtin_bit_cast(unsigned, __builtin_convertvector(v, bf16x2_t)); }
__device__ __forceinline__ unsigned cvt_pk4_fp8(float a, float b, float c, float d) { int w = __builtin_amdgcn_cvt_pk_fp8_f32(a, b, 0, false); w = __builtin_amdgcn_cvt_pk_fp8_f32(c, d, w, true); return (unsigned)w; }
__device__ __forceinline__ unsigned cvt_pk4_fp8_t(float a, float b, float c, float d) { int w = __builtin_amdgcn_cvt_pk_fp8_f32(a, b, __float_as_int(a), false); w = __builtin_amdgcn_cvt_pk_fp8_f32(c, d, w, true); return (unsigned)w; }
__device__ __forceinline__ float wave_sum(float v) {
#pragma unroll
    for (int o = 1; o < 64; o <<= 1) v += __shfl_xor(v, o);
    return v;
}
__device__ __forceinline__ int opaque_tid() { int t = threadIdx.x; asm volatile("" : "+v"(t)); return t; }
__device__ __forceinline__ float sigmoidf_(float x) { return __builtin_amdgcn_rcpf(1.0f + __expf(-x)); }

#define XB_TMO      128
#define XB_XCNT(j)  (256  + 64 * (j))
#define XB_XSUB(j)  (1280 + 64 * (j))
#define XB_XGEN(j)  (2304 + 64 * (j))
#define XB_TOP      3328
#define XB_TOPGEN   3392
#define XCD_BAR_WORDS 3456
#define XB_SPIN_CAP (1u << 18)
__device__ __forceinline__ unsigned xb_ld(unsigned* p)              { return __hip_atomic_load(p, __ATOMIC_RELAXED, __HIP_MEMORY_SCOPE_AGENT); }
__device__ __forceinline__ unsigned xb_add(unsigned* p, unsigned v) { return __hip_atomic_fetch_add(p, v, __ATOMIC_RELAXED, __HIP_MEMORY_SCOPE_AGENT); }
__device__ __forceinline__ unsigned xb_xcc_id() { return (unsigned)__builtin_amdgcn_s_getreg((3 << 11) | 20) & 0xFu; }
#define XB_SPIN(cond, bar) do { unsigned _sp = 0; while (cond) { __builtin_amdgcn_s_sleep(1); \
    if ((++_sp & 255u) == 0u) { if (xb_ld(&(bar)[XB_TMO])) break; if (_sp > XB_SPIN_CAP) { atomicAdd(&(bar)[XB_TMO], 1u); break; } } } } while (0)
struct XcdBarrier { unsigned* bar; unsigned x; volatile LAS unsigned* st; };
__device__ __forceinline__ XcdBarrier xcd_barrier_post(unsigned* bar, volatile LAS unsigned* st) {
    XcdBarrier b; b.bar = bar; b.x = xb_xcc_id(); b.st = st;
    if (threadIdx.x == 0) (void)xb_add(&bar[XB_XCNT(b.x)], 1u);
    return b;
}
__device__ __forceinline__ void xcd_barrier_complete(unsigned* bar, unsigned x, unsigned& nloc, unsigned& nx) {
    const unsigned G = gridDim.x * gridDim.y * gridDim.z;
    unsigned sum, cnt, mine, sp = 0u;
    for (;;) {
        sum = 0u; cnt = 0u; mine = 0u;
#pragma unroll
        for (unsigned j = 0; j < 16; ++j) { const unsigned c = xb_ld(&bar[XB_XCNT(j)]); sum += c; cnt += (c > 0u) ? 1u : 0u; mine = (j == x) ? c : mine; }
        if (sum == G) break;
        __builtin_amdgcn_s_sleep(1);
        if ((++sp & 255u) == 0u) { if (xb_ld(&bar[XB_TMO])) break; if (sp > XB_SPIN_CAP) { atomicAdd(&bar[XB_TMO], 1u); break; } }
    }
    nloc = mine > 0u ? mine : 1u; nx = cnt > 0u ? cnt : 1u;
}
__device__ __forceinline__ void xcd_barrier(const XcdBarrier& b) {
    asm volatile("s_waitcnt vmcnt(0)" ::: "memory");
    __syncthreads();
    if (threadIdx.x == 0) {
        unsigned* bar = b.bar;
        __builtin_amdgcn_s_waitcnt(0);
        unsigned nloc = b.st[0], nx = b.st[1];
        if (nloc == 0u) { xcd_barrier_complete(bar, b.x, nloc, nx); b.st[0] = nloc; b.st[1] = nx; }
        const unsigned old = xb_add(&bar[XB_XSUB(b.x)], 1u);
        const unsigned gen = old / nloc;
        if (old + 1u == (gen + 1u) * nloc) {
            __builtin_amdgcn_fence(__ATOMIC_RELEASE, "agent");
            asm volatile("s_waitcnt vmcnt(0)" ::: "memory");
            const unsigned og = xb_add(&bar[XB_TOP], 1u);
            const unsigned tg = og / nx;
            if (og + 1u == (tg + 1u) * nx) xb_add(&bar[XB_TOPGEN], 1u);
            else XB_SPIN(xb_ld(&bar[XB_TOPGEN]) == tg, bar);
            __builtin_amdgcn_fence(__ATOMIC_ACQUIRE, "agent");
            xb_add(&bar[XB_XGEN(b.x)], 1u);
            asm volatile("s_waitcnt vmcnt(0)" ::: "memory");
        } else {
            XB_SPIN(xb_ld(&bar[XB_XGEN(b.x)]) == gen, bar);
            __builtin_amdgcn_fence(__ATOMIC_ACQUIRE, "agent");
            asm volatile("s_waitcnt vmcnt(0)" ::: "memory");
        }
    }
    __syncthreads();
}

namespace pg8 {
constexpr int BM = 256, BK = 64, HALF = 128, HTB = HALF * BK * 2, STAGE_BYTES = 8 * HTB, NXCD = 8, WGM = 8;
__host__ __device__ __forceinline__ int lds_byte(int r, int c) { const int st = (r >> 4) * 2 + (c >> 5), rr = r & 15, cc = c & 31, ob = rr * 64 + cc * 2; return st * 1024 + (ob ^ (((ob >> 9) & 1) << 5)); }
__host__ __device__ __forceinline__ void stage_rc(int b, int& R, int& C) { const int st = b / 1024, sb = b % 1024, swz = sb ^ (((sb >> 9) & 1) << 5); R = (st >> 1) * 16 + swz / 64; C = (st & 1) * 32 + (swz % 64) / 2; }
__host__ __device__ __forceinline__ int perm32(int rho) { const int n = rho >> 4, i = rho & 15; return 8 * (i >> 2) + 4 * n + (i & 3); }

struct Unit { int pm, pn, pa, pb, ka, ord; };
struct Gemm { const bf16_t* A; const bf16_t* Bt; int K, lda, ldb; const LAS int* rt; int sw, sa; };

__host__ __device__ __forceinline__ void grid_unit(int L, int nM, int nN, int& pm, int& pn) {
    const int nwg = nM * nN; int wgid = L;
    { const int q = nwg / NXCD, r = nwg % NXCD, xcd = wgid % NXCD, off = wgid / NXCD; wgid = (xcd < r ? xcd * (q + 1) : r * (q + 1) + (xcd - r) * q) + off; }
    const int nig = WGM * nN, gid = wgid / nig, fm = gid * WGM, gsz = (nM - fm) < WGM ? (nM - fm) : WGM;
    pm = fm + ((wgid % nig) % gsz); pn = (wgid % nig) / gsz;
}
struct StaticOrder {
    int nM, nN, nwg, G, c;
    __device__ void init(int nM_, int nN_, int G_, int c_) { nM = nM_; nN = nN_; nwg = nM * nN; G = G_; c = c_; }
    __device__ __forceinline__ bool next(int i, Unit& u) const {
        const long L = (long)i * G + c; if (L >= nwg) return false;
        grid_unit((int)L, nM, nN, u.pm, u.pn); u.pa = u.pm; u.pb = u.pn; u.ka = 0; return true;
    }
};
struct VtOrder {
    int G, c;
    __device__ __forceinline__ bool next(int i, Unit& u) const {
        const long L = (long)i * G + c; if (L >= 8 * 68) return false;
        grid_unit((int)L, 8, 68, u.pm, u.pn); u.pa = u.pm; u.pb = u.pn; u.ka = 0; u.ord = i; return true;
    }
};
struct Gemm1Order {
    int G, c;
    __device__ __forceinline__ bool next(int i, Unit& u) const {
        const long L = (long)i * G + c; if (L >= 1612) return false;
        if (L < 1600) grid_unit((int)L, 64, 25, u.pm, u.pn);
        else { const int r = (int)L - 1600; u.pm = 64 + r / 3; const int q = r % 3; u.pn = q == 0 ? 6 : (q == 1 ? 7 : 24); }
        u.pa = u.pm; u.pb = u.pn; u.ka = 0; return true;
    }
};
struct FoldOrder {
    int G, c;
    __device__ __forceinline__ bool next(int i, Unit& u) const {
        const long L = (long)i * G + c; if (L >= 32) return false;
        const int g = (int)L >> 3; u.pm = (int)L & 7; u.pn = g; u.pa = u.pm; u.pb = g; u.ka = g * 256; return true;
    }
};
struct GroupedOrder {
    const LAS int* cum; int NC, G, c;
    __device__ __forceinline__ bool next(int i, Unit& u) const {
        const long L0 = (long)i * G + c; const long tot = (long)cum[32] * NC; if (L0 >= tot) return false;
        long L; { const int nwg = (int)tot, q = nwg / NXCD, r = nwg % NXCD, xcd = (int)(L0 % NXCD), off = (int)(L0 / NXCD); L = (xcd < r ? xcd * (q + 1) : r * (q + 1) + (xcd - r) * q) + off; }
        int e = 0;
        for (int q = 1; q < 32; ++q) if (L >= (long)cum[q] * NC) e = q;
        const int nt = cum[e + 1] - cum[e]; const int r = (int)(L - (long)cum[e] * NC);
        u.pm = u.pa = cum[e] + r % nt; u.pn = r / nt; u.pb = e * NC + u.pn; u.ka = 0; u.ord = i; return true;
    }
};

#ifndef PG8_SP2
#define PG8_SP2 true
#endif
#ifndef PG8_ALIGN
#define PG8_ALIGN true
#endif
#ifndef DMA_MMA_DEFAULT
#define DMA_MMA_DEFAULT false
#endif
template <class Epi, class Sched, bool ALIGN_EPI = PG8_ALIGN, bool SP2 = PG8_SP2, bool GATHER = false, bool FP8 = false>
__device__ __forceinline__ void gemm_phase(LAS unsigned char* lds, const Gemm g, const Sched& S, const Epi& E) {
    const int tid = opaque_tid(), wid = __builtin_amdgcn_readfirstlane(tid >> 6), lane = tid & 63, wr = wid >> 2, wc = wid & 3, fr = lane & 15, fq = lane >> 4;
    const int K = g.K, nt = K / BK;
    unsigned voffA[2], voffB[2];
#pragma unroll
    for (int i = 0; i < 2; ++i) { int R, C; stage_rc(tid * 16 + i * 8192, R, C); const int Rb = Epi::PERM ? ((R & ~31) + perm32(R & 31)) : R;
        voffA[i] = (unsigned)(R * g.lda + C) * 2u; voffB[i] = (unsigned)(Rb * g.ldb + C) * 2u; }
    const size_t kstep = (size_t)(BK * 2);
    const size_t hstepA = GATHER ? (size_t)0 : (size_t)HALF * g.lda * 2, hstepB = (size_t)HALF * g.ldb * 2;
    const size_t tstepA = GATHER ? (size_t)0 : (size_t)BM * g.lda * 2, tstepB = 2 * hstepB;
    int gR[2]; unsigned gC[2]; unsigned oA0[2] = {0u, 0u}, oA1[2] = {0u, 0u}, oN0[2] = {0u, 0u}, oN1[2] = {0u, 0u};
    if constexpr (GATHER) {
#pragma unroll
        for (int i = 0; i < 2; ++i) { int R, C; stage_rc(tid * 16 + i * 8192, R, C); gR[i] = R; gC[i] = (unsigned)C * 2u; }
    }
#define PG8_GOFF(o0, o1, u_) do { _Pragma("unroll") for (int _i = 0; _i < 2; ++_i) { \
        o0[_i] = (unsigned)g.rt[(u_) * 256 + gR[_i]] * (unsigned)(g.lda * 2) + gC[_i]; o1[_i] = (unsigned)g.rt[(u_) * 256 + 128 + gR[_i]] * (unsigned)(g.lda * 2) + gC[_i]; } } while (0)
    const unsigned ldsw = (unsigned)wid * 1024u;
    const int aoff = lds_byte(wr * 64 + fr, fq * 8), boff = lds_byte(wc * 32 + fr, fq * 8);
    const int fcol = (fq >> 1) * 32 + (fq & 1) * 16;
    const int aoffF0 = lds_byte(wr * 64 + fr, fcol), aoffF1 = lds_byte(wr * 64 + fr, fcol + 8), boffF0 = lds_byte(wc * 32 + fr, fcol), boffF1 = lds_byte(wc * 32 + fr, fcol + 8);
    const int scw = ((g.sw ? g.sw : 127) & 0xff) * 0x01010101, sc1 = ((g.sa ? g.sa : 127) & 0xff) * 0x01010101;
#define PG8_SA(b, h) (((b) * 2 + (h)) * HTB)
#define PG8_SB(b, h) ((4 + (b) * 2 + (h)) * HTB)
#define PG8_STAGE(bufoff, gbase, voff) do { _Pragma("unroll") for (int _i = 0; _i < 2; ++_i) \
        __builtin_amdgcn_global_load_lds((const unsigned*)((const char*)(gbase) + (voff)[_i]), (LAS unsigned*)(lds + (bufoff) + ldsw + _i * 8192), 16, 0, 0); } while (0)
#define PG8_LD8(off0, off1) __builtin_shufflevector(*(const LAS i32x4*)(lds + (off0)), *(const LAS i32x4*)(lds + (off1)), 0, 1, 2, 3, 4, 5, 6, 7)
#define PG8_LDA(dst, b, h) do { if constexpr (FP8) { _Pragma("unroll") for (int m = 0; m < 4; ++m) dst##8[m] = PG8_LD8(PG8_SA(b, h) + aoffF0 + m * 2048, PG8_SA(b, h) + aoffF1 + m * 2048); } \
        else { _Pragma("unroll") for (int m = 0; m < 4; ++m) _Pragma("unroll") for (int k = 0; k < 2; ++k) dst[m][k] = *(const LAS bf16x8*)(lds + PG8_SA(b, h) + aoff + m * 2048 + k * 1024); } } while (0)
#define PG8_LDB(dst, b, h) do { if constexpr (FP8) { _Pragma("unroll") for (int n = 0; n < 2; ++n) dst##8[n] = PG8_LD8(PG8_SB(b, h) + boffF0 + n * 2048, PG8_SB(b, h) + boffF1 + n * 2048); } \
        else { _Pragma("unroll") for (int n = 0; n < 2; ++n) _Pragma("unroll") for (int k = 0; k < 2; ++k) dst[n][k] = *(const LAS bf16x8*)(lds + PG8_SB(b, h) + boff + n * 2048 + k * 1024); } } while (0)
#define PG8_MMA(ai, bj, At, Bt) do { __builtin_amdgcn_s_setprio(1); if constexpr (FP8) { _Pragma("unroll") for (int m = 0; m < 4; ++m) _Pragma("unroll") for (int n = 0; n < 2; ++n) \
        asm volatile("v_mfma_scale_f32_16x16x128_f8f6f4 %0, %1, %2, %0, %3, %4 op_sel_hi:[0,0,0]" : "+v"(acc[ai][bj][m][n]) : "v"(Bt##8[n]), "v"(At##8[m]), "v"(scw), "v"(sc1)); } \
        else { _Pragma("unroll") for (int m = 0; m < 4; ++m) _Pragma("unroll") for (int n = 0; n < 2; ++n) _Pragma("unroll") for (int k = 0; k < 2; ++k) \
        acc[ai][bj][m][n] = __builtin_amdgcn_mfma_f32_16x16x32_bf16(Bt[n][k], At[m][k], acc[ai][bj][m][n], 0, 0, 0); } __builtin_amdgcn_s_setprio(0); } while (0)
#define PG8_MMA_H(ai, bj, At, Bt, m0_) do { if constexpr (FP8) { _Pragma("unroll") for (int m = (m0_); m < (m0_) + 2; ++m) _Pragma("unroll") for (int n = 0; n < 2; ++n) \
        asm volatile("v_mfma_scale_f32_16x16x128_f8f6f4 %0, %1, %2, %0, %3, %4 op_sel_hi:[0,0,0]" : "+v"(acc[ai][bj][m][n]) : "v"(Bt##8[n]), "v"(At##8[m]), "v"(scw), "v"(sc1)); } \
        else { _Pragma("unroll") for (int m = (m0_); m < (m0_) + 2; ++m) _Pragma("unroll") for (int n = 0; n < 2; ++n) _Pragma("unroll") for (int k = 0; k < 2; ++k) \
        acc[ai][bj][m][n] = __builtin_amdgcn_mfma_f32_16x16x32_bf16(Bt[n][k], At[m][k], acc[ai][bj][m][n], 0, 0, 0); } } while (0)
#define PG8_MMA2(ai, At, P1, P2, P3) do { __builtin_amdgcn_s_setprio(1); PG8_MMA_H(ai, 0, At, B0, 0); PG8_SCHED; P1; PG8_SCHED; PG8_MMA_H(ai, 0, At, B0, 2); PG8_SCHED; P2; PG8_SCHED; \
        PG8_MMA_H(ai, 1, At, B1, 0); PG8_SCHED; P3; PG8_SCHED; PG8_MMA_H(ai, 1, At, B1, 2); __builtin_amdgcn_s_setprio(0); } while (0)
#define PG8_WAIT_V(n) asm volatile("s_waitcnt vmcnt(" #n ")" ::: "memory")
#define PG8_WAIT_L(n) asm volatile("s_waitcnt lgkmcnt(" #n ")" ::: "memory")
#define PG8_BAR __builtin_amdgcn_s_barrier()
#define PG8_SCHED __builtin_amdgcn_sched_barrier(0)
    Unit cur, nxt; int ui = 0;
    if (!S.next(0, cur)) return;
    f32x4 acc[2][2][4][2];
#pragma unroll
    for (int a = 0; a < 2; ++a)
#pragma unroll
        for (int b = 0; b < 2; ++b)
#pragma unroll
            for (int m = 0; m < 4; ++m)
#pragma unroll
                for (int n = 0; n < 2; ++n) acc[a][b][m][n] = (f32x4){0.f, 0.f, 0.f, 0.f};
    bf16x8 At[4][2], B0[2][2], B1[2][2]; i32x8 At8[4], B08[2], B18[2];
    const char* cA = (const char*)g.A + (size_t)cur.pa * tstepA + (size_t)cur.ka * 2; const char* cB = (const char*)g.Bt + (size_t)cur.pb * tstepB;
    if constexpr (GATHER) PG8_GOFF(oA0, oA1, 0);
    const unsigned* vAc0 = GATHER ? oA0 : voffA; const unsigned* vAc1 = GATHER ? oA1 : voffA;
    if constexpr (SP2) {
        PG8_STAGE(PG8_SB(0, 0), cB, voffB); PG8_STAGE(PG8_SB(0, 1), cB + hstepB, voffB); PG8_STAGE(PG8_SA(0, 0), cA, vAc0); PG8_STAGE(PG8_SA(0, 1), cA + hstepA, vAc1);
        if (wr == 1) PG8_BAR;
        PG8_WAIT_V(2); PG8_BAR;
        PG8_STAGE(PG8_SB(1, 0), cB + kstep, voffB); PG8_STAGE(PG8_SA(1, 0), cA + kstep, vAc0); PG8_STAGE(PG8_SB(1, 1), cB + hstepB + kstep, voffB);
        PG8_WAIT_V(6); PG8_BAR;
    } else {
        PG8_STAGE(PG8_SB(0, 0), cB, voffB); PG8_STAGE(PG8_SA(0, 0), cA, vAc0); PG8_STAGE(PG8_SB(0, 1), cB + hstepB, voffB); PG8_STAGE(PG8_SA(0, 1), cA + hstepA, vAc1);
        if (wr == 1) PG8_BAR;
        PG8_WAIT_V(4); PG8_BAR;
        PG8_STAGE(PG8_SB(1, 0), cB + kstep, voffB); PG8_STAGE(PG8_SA(1, 0), cA + kstep, vAc0); PG8_STAGE(PG8_SB(1, 1), cB + hstepB + kstep, voffB);
        PG8_WAIT_V(6); PG8_BAR;
    }
    for (;;) {
        const bool has_next = S.next(ui + 1, nxt);
        const char* nA = has_next ? (const char*)g.A + (size_t)nxt.pa * tstepA + (size_t)nxt.ka * 2 : cA; const char* nB = has_next ? (const char*)g.Bt + (size_t)nxt.pb * tstepB : cB;
        if constexpr (GATHER) { if (has_next) PG8_GOFF(oN0, oN1, ui + 1); else {
#pragma unroll
            for (int _i = 0; _i < 2; ++_i) { oN0[_i] = oA0[_i]; oN1[_i] = oA1[_i]; } } }
        for (int t = 0; t < nt; t += 2) {
            const bool last = (t == nt - 2);
            const char* a1 = cA + (size_t)(t + 1) * kstep;
            const char* a2 = last ? nA : cA + (size_t)(t + 2) * kstep; const char* b2 = last ? nB : cB + (size_t)(t + 2) * kstep;
            const char* a3 = a2 + kstep; const char* b3 = b2 + kstep;
            unsigned sT0[2], sT1[2];
#pragma unroll
            for (int _i = 0; _i < 2; ++_i) { sT0[_i] = GATHER ? (last ? oN0[_i] : oA0[_i]) : voffA[_i]; sT1[_i] = GATHER ? (last ? oN1[_i] : oA1[_i]) : voffA[_i]; }
            if constexpr (SP2) {
            if constexpr (Epi::DMA_MMA && FP8) {
            PG8_LDB(B0, 0, 0); PG8_LDB(B1, 0, 1); PG8_SCHED; PG8_LDA(At, 0, 0);
            PG8_WAIT_V(6); PG8_WAIT_L(0); PG8_BAR; PG8_MMA2(0, At, , PG8_STAGE(PG8_SA(1, 1), a1 + hstepA, vAc1), ); PG8_BAR; PG8_SCHED;
            PG8_LDA(At, 0, 1);
            PG8_WAIT_V(2); PG8_WAIT_L(0); PG8_BAR; PG8_MMA2(1, At, PG8_STAGE(PG8_SB(0, 0), b2, voffB), PG8_STAGE(PG8_SB(0, 1), b2 + hstepB, voffB), PG8_STAGE(PG8_SA(0, 0), a2, sT0)); PG8_BAR; PG8_SCHED;
            PG8_LDB(B0, 1, 0); PG8_LDB(B1, 1, 1); PG8_SCHED; PG8_LDA(At, 1, 0);
            PG8_WAIT_V(6); PG8_WAIT_L(0); PG8_BAR; PG8_MMA2(0, At, , PG8_STAGE(PG8_SA(0, 1), a2 + hstepA, sT1), ); PG8_BAR; PG8_SCHED;
            PG8_LDA(At, 1, 1);
            PG8_WAIT_V(2); PG8_WAIT_L(0); PG8_BAR; PG8_MMA2(1, At, PG8_STAGE(PG8_SB(1, 0), b3, voffB), PG8_STAGE(PG8_SB(1, 1), b3 + hstepB, voffB), PG8_STAGE(PG8_SA(1, 0), a3, sT0)); PG8_BAR; PG8_SCHED;
            } else {
            PG8_LDB(B0, 0, 0); PG8_LDB(B1, 0, 1); PG8_SCHED; PG8_LDA(At, 0, 0); PG8_STAGE(PG8_SA(1, 1), a1 + hstepA, vAc1);
            PG8_WAIT_V(8); PG8_WAIT_L(0); PG8_BAR; PG8_MMA(0, 0, At, B0); PG8_MMA(0, 1, At, B1); PG8_BAR; PG8_SCHED;
            PG8_LDA(At, 0, 1); PG8_STAGE(PG8_SB(0, 0), b2, voffB); PG8_STAGE(PG8_SB(0, 1), b2 + hstepB, voffB); PG8_STAGE(PG8_SA(0, 0), a2, sT0);
            PG8_WAIT_V(8); PG8_WAIT_L(0); PG8_BAR; PG8_MMA(1, 0, At, B0); PG8_MMA(1, 1, At, B1); PG8_BAR; PG8_SCHED;
            PG8_LDB(B0, 1, 0); PG8_LDB(B1, 1, 1); PG8_SCHED; PG8_LDA(At, 1, 0); PG8_STAGE(PG8_SA(0, 1), a2 + hstepA, sT1);
            PG8_WAIT_V(8); PG8_WAIT_L(0); PG8_BAR; PG8_MMA(0, 0, At, B0); PG8_MMA(0, 1, At, B1); PG8_BAR; PG8_SCHED;
            PG8_LDA(At, 1, 1); PG8_STAGE(PG8_SB(1, 0), b3, voffB); PG8_STAGE(PG8_SB(1, 1), b3 + hstepB, voffB); PG8_STAGE(PG8_SA(1, 0), a3, sT0);
            PG8_WAIT_V(8); PG8_WAIT_L(0); PG8_BAR; PG8_MMA(1, 0, At, B0); PG8_MMA(1, 1, At, B1); PG8_BAR; PG8_SCHED;
            }
            } else {
            PG8_LDB(B0, 0, 0); PG8_SCHED; PG8_LDA(At, 0, 0); PG8_STAGE(PG8_SA(1, 1), a1 + hstepA, vAc1);
            PG8_WAIT_L(8); PG8_BAR; PG8_WAIT_L(0); PG8_MMA(0, 0, At, B0); PG8_BAR; PG8_SCHED;
            PG8_LDB(B1, 0, 1); PG8_STAGE(PG8_SB(0, 0), b2, voffB);
            PG8_BAR; PG8_WAIT_L(0); PG8_MMA(0, 1, At, B1); PG8_BAR;
            PG8_LDA(At, 0, 1); PG8_STAGE(PG8_SA(0, 0), a2, sT0);
            PG8_BAR; PG8_WAIT_L(0); PG8_MMA(1, 0, At, B0); PG8_BAR; PG8_SCHED;
            PG8_STAGE(PG8_SB(0, 1), b2 + hstepB, voffB);
            PG8_WAIT_V(6); PG8_BAR; PG8_MMA(1, 1, At, B1); PG8_BAR;
            PG8_LDB(B0, 1, 0); PG8_SCHED; PG8_LDA(At, 1, 0); PG8_STAGE(PG8_SA(0, 1), a2 + hstepA, sT1);
            PG8_WAIT_L(8); PG8_BAR; PG8_WAIT_L(0); PG8_MMA(0, 0, At, B0); PG8_BAR; PG8_SCHED;
            PG8_LDB(B1, 1, 1); PG8_STAGE(PG8_SB(1, 0), b3, voffB);
            PG8_BAR; PG8_WAIT_L(0); PG8_MMA(0, 1, At, B1); PG8_BAR;
            PG8_LDA(At, 1, 1); PG8_STAGE(PG8_SA(1, 0), a3, sT0);
            PG8_BAR; PG8_WAIT_L(0); PG8_MMA(1, 0, At, B0); PG8_BAR; PG8_SCHED;
            PG8_STAGE(PG8_SB(1, 1), b3 + hstepB, voffB);
            PG8_WAIT_V(6); PG8_BAR; PG8_MMA(1, 1, At, B1); PG8_BAR;
                    }
        }
        if constexpr (FP8) asm volatile("s_nop 15\n\ts_nop 15\n\ts_nop 15\n\ts_nop 15" ::: "memory");
        if constexpr (ALIGN_EPI) { if (wr == 0) PG8_BAR; }
        { const int te = opaque_tid(), we = __builtin_amdgcn_readfirstlane(te >> 6);
          E(acc, cur, we >> 2, we & 3, te & 15, (te & 63) >> 4); }
        if (!has_next) break;
#pragma unroll
        for (int a = 0; a < 2; ++a)
#pragma unroll
            for (int b = 0; b < 2; ++b)
#pragma unroll
                for (int m = 0; m < 4; ++m)
#pragma unroll
                    for (int n = 0; n < 2; ++n) acc[a][b][m][n] = (f32x4){0.f, 0.f, 0.f, 0.f};
        cur = nxt; cA = nA; cB = nB; ++ui;
        if constexpr (GATHER) {
#pragma unroll
            for (int _i = 0; _i < 2; ++_i) { oA0[_i] = oN0[_i]; oA1[_i] = oN1[_i]; } }
        if constexpr (ALIGN_EPI) { if (wr == 1) PG8_BAR; }
    }
    PG8_WAIT_V(0);
    if constexpr (!ALIGN_EPI) { if (wr == 0) PG8_BAR; }
    PG8_BAR;
#undef PG8_GOFF
#undef PG8_LD8
#undef PG8_SA
#undef PG8_SB
#undef PG8_STAGE
#undef PG8_LDA
#undef PG8_LDB
#undef PG8_MMA
#undef PG8_MMA_H
#undef PG8_MMA2
#undef PG8_WAIT_V
#undef PG8_WAIT_L
#undef PG8_BAR
#undef PG8_SCHED
}

__device__ __forceinline__ u32x4 pack8(const f32x4 v0, const f32x4 v1) { u32x4 w; w.x = cvt_pk_bf16(v0[0], v0[1]); w.y = cvt_pk_bf16(v0[2], v0[3]); w.z = cvt_pk_bf16(v1[0], v1[1]); w.w = cvt_pk_bf16(v1[2], v1[3]); return w; }
__device__ __forceinline__ float fq_sum(float s) {
    { auto r = __builtin_amdgcn_permlane16_swap(__float_as_uint(s), __float_as_uint(s), false, false); s = __uint_as_float(r[0]) + __uint_as_float(r[1]); }
    { auto r = __builtin_amdgcn_permlane32_swap(__float_as_uint(s), __float_as_uint(s), false, false); s = __uint_as_float(r[0]) + __uint_as_float(r[1]); }
    return s;
}
__device__ __forceinline__ float sq4(const f32x4 v) { return (v[0] * v[0] + v[1] * v[1]) + (v[2] * v[2] + v[3] * v[3]); }
__device__ __forceinline__ void rope8(f32x4& v0, f32x4& v1, const float* cs  ) {
    const f32x4 a = *(const f32x4*)cs, b = *(const f32x4*)(cs + 4);
    f32x4 o0, o1;
    o0[0] = v0[0] * a[0] - v0[1] * a[1]; o0[1] = v0[1] * a[0] + v0[0] * a[1];
    o0[2] = v0[2] * a[2] - v0[3] * a[3]; o0[3] = v0[3] * a[2] + v0[2] * a[3];
    o1[0] = v1[0] * b[0] - v1[1] * b[1]; o1[1] = v1[1] * b[0] + v1[0] * b[1];
    o1[2] = v1[2] * b[2] - v1[3] * b[3]; o1[3] = v1[3] * b[2] + v1[2] * b[3];
    v0 = o0; v1 = o1;
}

__device__ __forceinline__ void rope8v(f32x4& v0, f32x4& v1, const f32x4 a, const f32x4 b) {
    f32x4 o0, o1;
    o0[0] = v0[0] * a[0] - v0[1] * a[1]; o0[1] = v0[1] * a[0] + v0[0] * a[1];
    o0[2] = v0[2] * a[2] - v0[3] * a[3]; o0[3] = v0[3] * a[2] + v0[2] * a[3];
    o1[0] = v1[0] * b[0] - v1[1] * b[1]; o1[1] = v1[1] * b[0] + v1[0] * b[1];
    o1[2] = v1[2] * b[2] - v1[3] * b[3]; o1[3] = v1[3] * b[2] + v1[2] * b[3];
    v0 = o0; v1 = o1;
}
typedef const f32x4 (&AccRef)[2][2][4][2];

struct EpiG1 {
    static constexpr bool PERM = true; static constexpr bool DMA_MMA = true;
    bf16_t *pool_in, *qc, *kvc, *kr, *gates; float *ssq_q, *ssq_kv; const float* cs;
    template <int MODE  >
    __device__ __forceinline__ void tile(AccRef acc, bf16_t* base, int ld, int col0, float* ssq, int slot, int row0, int fq) const {
#pragma unroll
        for (int ai = 0; ai < 2; ++ai)
#pragma unroll
            for (int m = 0; m < 4; ++m) { const int row = row0 + ai * HALF + m * 16; bf16_t* rowp = base + (size_t)row * ld + col0; float s = 0.f;
#pragma unroll
                for (int bj = 0; bj < 2; ++bj) { f32x4 v0 = acc[ai][bj][m][0], v1 = acc[ai][bj][m][1];
                    if (MODE == 2) s += sq4(v0) + sq4(v1);
                    if (MODE == 1) {
#pragma unroll
                        for (int j = 0; j < 4; ++j) { v0[j] = sigmoidf_(v0[j]); v1[j] = sigmoidf_(v1[j]); } }
                    if (MODE == 2) { u32x2 w8; w8.x = cvt_pk4_fp8(v0[0], v0[1], v0[2], v0[3]); w8.y = cvt_pk4_fp8(v1[0], v1[1], v1[2], v1[3]); *(u32x2*)((unsigned char*)base + (size_t)row * ld + col0 + bj * HALF) = w8; }
                    else *(u32x4*)(rowp + bj * HALF) = pack8(v0, v1); }
                if (MODE == 2) { s = fq_sum(s); if (fq == 0) ssq[(size_t)row * 8 + slot] = s; } }
    }
    __device__ __forceinline__ void operator()(AccRef acc, const Unit& u, int wr, int wc, int fr, int fq) const {
        const int row0 = u.pm * BM + wr * 64 + fr, cl = wc * 32 + 8 * fq, pn = u.pn;
        if (pn < 4) tile<0>(acc, pool_in, 1024, pn * 256 + cl, nullptr, 0, row0, fq);
        else if (pn < 6) tile<2>(acc, qc, 512, (pn - 4) * 256 + cl, ssq_q, (pn - 4) * 4 + wc, row0, fq);
        else if (pn < 8) tile<2>(acc, kvc, 512, (pn - 6) * 256 + cl, ssq_kv, (pn - 6) * 4 + wc, row0, fq);
        else if (pn < 24) tile<1>(acc, gates, 4096, (pn - 8) * 256 + cl, nullptr, 0, row0, fq);
        else tile<0>(acc, kr, 256, cl, nullptr, 0, row0, fq);
    }
};
struct EpiQ {
    static constexpr bool PERM = true; static constexpr bool DMA_MMA = DMA_MMA_DEFAULT;
    bf16_t* q; const float* ssq; const float* cs;
    __device__ __forceinline__ void operator()(AccRef acc, const Unit& u, int wr, int wc, int fr, int fq) const {
        const int row0 = u.pm * BM + wr * 64 + fr, col0 = u.pn * BM + wc * 32 + 8 * fq; const bool rope = u.pn >= 8;
        f32x2 part[2][4];
#pragma unroll
        for (int ai = 0; ai < 2; ++ai)
#pragma unroll
            for (int m = 0; m < 4; ++m) part[ai][m] = *(const f32x2*)(ssq + (size_t)(row0 + ai * HALF + m * 16) * 8 + 2 * fq);
        f32x4 csv[4][2];
        if (rope) {
            if (wc & 1) {
#pragma unroll
                for (int m = 0; m < 4; ++m) { const float* p = cs + ((m * 16 + fr) * 16 + 4 * fq) * 2; csv[m][0] = *(const f32x4*)p; csv[m][1] = *(const f32x4*)(p + 4); }
            } else {
#pragma unroll
                for (int ai = 0; ai < 2; ++ai) { const float* p = cs + ((((u.pm * 4 + wr + ai * 2) & 63)) * 16 + 4 * fq) * 2; csv[ai][0] = *(const f32x4*)p; csv[ai][1] = *(const f32x4*)(p + 4); csv[2 + ai][0] = csv[ai][0]; csv[2 + ai][1] = csv[ai][1]; }
            }
        }
        float rq[2][4];
#pragma unroll
        for (int ai = 0; ai < 2; ++ai)
#pragma unroll
            for (int m = 0; m < 4; ++m) rq[ai][m] = rsqrtf(fq_sum(part[ai][m][0] + part[ai][m][1]) * (1.0f / 512.0f) + EPS) * 0.8329403702f;
#pragma unroll
        for (int ai = 0; ai < 2; ++ai)
#pragma unroll
            for (int m = 0; m < 4; ++m) { const int row = row0 + ai * HALF + m * 16;
#pragma unroll
                for (int bj = 0; bj < 2; ++bj) { f32x4 v0 = acc[ai][bj][m][0] * rq[ai][m], v1 = acc[ai][bj][m][1] * rq[ai][m];
                    if (rope) { if (wc & 1) rope8v(v0, v1, csv[m][0], csv[m][1]); else rope8v(v0, v1, csv[ai][0], csv[ai][1]); }
                    u32x2 w8; w8.x = cvt_pk4_fp8(v0[0], v0[1], v0[2], v0[3]); w8.y = cvt_pk4_fp8(v1[0], v1[1], v1[2], v1[3]);
                    *(u32x2*)((unsigned char*)q + (size_t)row * NQ + col0 + bj * HALF) = w8; } }
    }
};
struct EpiK {
    static constexpr bool PERM = true; static constexpr bool DMA_MMA = DMA_MMA_DEFAULT;
    unsigned char* kn; const float* ssq;
    __device__ __forceinline__ void operator()(AccRef acc, const Unit& u, int wr, int wc, int fr, int fq) const {
        const int row0 = u.pm * BM + wr * 64 + fr, col0 = u.pn * BM + wc * 32 + 8 * fq;
        f32x2 part[2][4];
#pragma unroll
        for (int ai = 0; ai < 2; ++ai)
#pragma unroll
            for (int m = 0; m < 4; ++m) part[ai][m] = *(const f32x2*)(ssq + (size_t)(row0 + ai * HALF + m * 16) * 8 + 2 * fq);
        float rk[2][4];
#pragma unroll
        for (int ai = 0; ai < 2; ++ai)
#pragma unroll
            for (int m = 0; m < 4; ++m) rk[ai][m] = rsqrtf(fq_sum(part[ai][m][0] + part[ai][m][1]) * (1.0f / 512.0f) + EPS);
#pragma unroll
        for (int ai = 0; ai < 2; ++ai)
#pragma unroll
            for (int m = 0; m < 4; ++m) { const int row = row0 + ai * HALF + m * 16;
#pragma unroll
                for (int bj = 0; bj < 2; ++bj) { const f32x4 k0 = acc[ai][bj][m][0] * rk[ai][m], k1 = acc[ai][bj][m][1] * rk[ai][m];
                    u32x2 w8; w8.x = cvt_pk4_fp8(k0[0], k0[1], k0[2], k0[3]); w8.y = cvt_pk4_fp8(k1[0], k1[1], k1[2], k1[3]);
                    *(u32x2*)(kn + (size_t)row * 2048 + col0 + bj * HALF) = w8; } }
    }
};
struct EpiVT {
    static constexpr bool PERM = true; static constexpr bool DMA_MMA = DMA_MMA_DEFAULT;
    unsigned char* vt; const LAS float* rkt;
    __device__ __forceinline__ void operator()(AccRef acc, const Unit& u, int wr, int wc, int fr, int fq) const {
        const int row0 = u.pm * BM + wr * 64 + fr, cl = wc * 32 + 8 * fq;
        f32x4 s0[2], s1[2];
#pragma unroll
        for (int bj = 0; bj < 2; ++bj) { s0[bj] = *(const LAS f32x4*)(rkt + u.ord * 256 + bj * HALF + cl); s1[bj] = *(const LAS f32x4*)(rkt + u.ord * 256 + bj * HALF + cl + 4); }
#pragma unroll
        for (int ai = 0; ai < 2; ++ai)
#pragma unroll
            for (int m = 0; m < 4; ++m) { const int row = row0 + ai * HALF + m * 16;
#pragma unroll
                for (int bj = 0; bj < 2; ++bj) { const f32x4 v0 = acc[ai][bj][m][0] * s0[bj], v1 = acc[ai][bj][m][1] * s1[bj];
                    u32x2 w8; w8.x = cvt_pk4_fp8(v0[0], v0[1], v0[2], v0[3]); w8.y = cvt_pk4_fp8(v1[0], v1[1], v1[2], v1[3]);
                    *(u32x2*)(vt + (size_t)row * TA + u.pn * BM + bj * HALF + cl) = w8; } }
    }
};
struct EpiPlain {
    static constexpr bool PERM = true; static constexpr bool DMA_MMA = true;
    bf16_t* o; int ldc;
    __device__ __forceinline__ void operator()(AccRef acc, const Unit& u, int wr, int wc, int fr, int fq) const {
        const int row0 = u.pm * BM + wr * 64 + fr, col0 = u.pn * BM + wc * 32 + 8 * fq;
#pragma unroll
        for (int ai = 0; ai < 2; ++ai)
#pragma unroll
            for (int m = 0; m < 4; ++m) { const int row = row0 + ai * HALF + m * 16;
#pragma unroll
                for (int bj = 0; bj < 2; ++bj) *(u32x4*)(o + (size_t)row * ldc + col0 + bj * HALF) = pack8(acc[ai][bj][m][0], acc[ai][bj][m][1]); }
    }
};
__device__ __forceinline__ void unpack8(const u32x4 w, f32x4& a, f32x4& b) { a[0] = bflo(w.x); a[1] = bfhi(w.x); a[2] = bflo(w.y); a[3] = bfhi(w.y); b[0] = bflo(w.z); b[1] = bfhi(w.z); b[2] = bflo(w.w); b[3] = bfhi(w.w); }
template <bool ADD, bool O8 = false> struct EpiGate {
    static constexpr bool PERM = true; static constexpr bool DMA_MMA = true;
    bf16_t* o; const bf16_t* prev; const bf16_t* gates; int gcol0;
    __device__ __forceinline__ void operator()(AccRef acc, const Unit& u, int wr, int wc, int fr, int fq) const {
        const int row0 = u.pm * BM + wr * 64 + fr, col0 = u.pn * BM + wc * 32 + 8 * fq;
#pragma unroll
        for (int ai = 0; ai < 2; ++ai) {
            u32x4 gw[4][2], pw[4][2];
#pragma unroll
            for (int m = 0; m < 4; ++m)
#pragma unroll
                for (int bj = 0; bj < 2; ++bj) { const int row = row0 + ai * HALF + m * 16, col = col0 + bj * HALF;
                    gw[m][bj] = *(const u32x4*)(gates + (size_t)row * 4096 + gcol0 + col);
                    if (ADD) pw[m][bj] = *(const u32x4*)(prev + (size_t)row * DM + col); }
#pragma unroll
            for (int m = 0; m < 4; ++m)
#pragma unroll
                for (int bj = 0; bj < 2; ++bj) { const int row = row0 + ai * HALF + m * 16, col = col0 + bj * HALF;
                    f32x4 g0, g1; unpack8(gw[m][bj], g0, g1);
                    f32x4 v0 = acc[ai][bj][m][0] * g0, v1 = acc[ai][bj][m][1] * g1;
                    if (ADD) { f32x4 p0, p1; unpack8(pw[m][bj], p0, p1); v0 += p0; v1 += p1; }
                    if constexpr (O8) { v0 = v0 * 16.0f; v1 = v1 * 16.0f; u32x2 w8; w8.x = cvt_pk4_fp8(v0[0], v0[1], v0[2], v0[3]); w8.y = cvt_pk4_fp8(v1[0], v1[1], v1[2], v1[3]);
                        *(u32x2*)((unsigned char*)o + (size_t)row * DM + col) = w8; }
                    else *(u32x4*)(o + (size_t)row * DM + col) = pack8(v0, v1); }
        }
    }
};
struct EpiGU {
    static constexpr bool PERM = true; static constexpr bool DMA_MMA = DMA_MMA_DEFAULT;
    bf16_t* act;
    __device__ __forceinline__ void operator()(AccRef acc, const Unit& u, int wr, int wc, int fr, int fq) const {
        const int row0 = u.pm * BM + wr * 64 + fr, col0 = u.pn * 128 + wc * 16 + 4 * fq;
#pragma unroll
        for (int ai = 0; ai < 2; ++ai)
#pragma unroll
            for (int m = 0; m < 4; ++m) { const int row = row0 + ai * HALF + m * 16;
#pragma unroll
                for (int bj = 0; bj < 2; ++bj) { const f32x4 gt = acc[ai][bj][m][0], up = acc[ai][bj][m][1]; f32x4 v;
#pragma unroll
                    for (int j = 0; j < 4; ++j) v[j] = gt[j] * sigmoidf_(gt[j]) * up[j];
                    *(unsigned*)((unsigned char*)act + (size_t)row * DE + col0 + bj * 64) = cvt_pk4_fp8(v[0], v[1], v[2], v[3]); } }
    }
};
struct EpiDown {
    static constexpr bool PERM = true; static constexpr bool DMA_MMA = DMA_MMA_DEFAULT;
    bf16_t* y2; const LAS int* tkt; const LAS float* wt;
    static constexpr int DOWN_TAB = 8;
    __device__ __forceinline__ void operator()(AccRef acc, const Unit& u, int wr, int wc, int fr, int fq) const {
        const int col0 = u.pn * BM + wc * 32 + 8 * fq, lr = u.ord * 256 + wr * 64 + fr;
        int tk[2][4]; float w[2][4];
#pragma unroll
        for (int ai = 0; ai < 2; ++ai)
#pragma unroll
            for (int m = 0; m < 4; ++m) { tk[ai][m] = tkt[lr + ai * HALF + m * 16]; w[ai][m] = wt[lr + ai * HALF + m * 16]; }
#pragma unroll
        for (int ai = 0; ai < 2; ++ai)
#pragma unroll
            for (int m = 0; m < 4; ++m) { const int t = tk[ai][m];
                if (t >= 0) { unsigned char* dst = (unsigned char*)y2 + ((size_t)(t & 1) * T + (size_t)(t >> 1)) * DM + col0; const float w8s = w[ai][m] * 8.0f;
#pragma unroll
                    for (int bj = 0; bj < 2; ++bj) { const f32x4 v0 = acc[ai][bj][m][0] * w8s, v1 = acc[ai][bj][m][1] * w8s; u32x2 w8; w8.x = cvt_pk4_fp8(v0[0], v0[1], v0[2], v0[3]); w8.y = cvt_pk4_fp8(v1[0], v1[1], v1[2], v1[3]);
                        *(u32x2*)(dst + bj * HALF) = w8; } } }
    }
};
}

namespace att {
constexpr int NW = 8, QBLK = 32, KVBLK = 64;
constexpr float SCALE = 0.07216878364870322f;
constexpr float QSCALE = SCALE * 1.4426950408889634f * 8.0f;
constexpr float THR2 = 1.5f * 1.4426950408889634f;
constexpr float THR = 1.5f;
constexpr int LDQ = NQ, LDKN = 2048, LDVT = TA, LDKR = 64, LDO = DM;
constexpr int KP8 = 144, RP8 = 80;
constexpr int VP8 = 80;
constexpr int SHM_V = 128 * VP8, SHM_K = KVBLK * KP8, SHM_KR = KVBLK * RP8;
constexpr int NSLOT = 4;
constexpr int OFF_V = 0, OFF_K = NSLOT * SHM_V, OFF_KR = OFF_K + NSLOT * SHM_K, OFF_WS = OFF_KR + NSLOT * SHM_KR, SHM_ATTN = OFF_WS + NW * 64 * 4;
#define KSWZ(row, colB) ((row) * KP + (colB))
#define RSWZ(row, colB) ((row) * RP + (colB))
#define SBAR() __builtin_amdgcn_sched_barrier(0)
__device__ __forceinline__ int crow(int r, int hi) { return (r & 3) + 8 * (r >> 2) + 4 * hi; }
__device__ __forceinline__ void partialSM(f32x16& p0, f32x16& p1, float& m_reg, float& mn, float& alpha) {
  float pmax = p0[0];
#pragma unroll
  for (int r = 1; r < 16; ++r) pmax = fmaxf(pmax, p0[r]);
#pragma unroll
  for (int r = 0; r < 16; ++r) pmax = fmaxf(pmax, p1[r]);
  { auto rr = __builtin_amdgcn_permlane32_swap(__float_as_uint(pmax), __float_as_uint(pmax), false, false);
    pmax = fmaxf(__uint_as_float(rr[0]), __uint_as_float(rr[1])); }
  if (__builtin_expect(__all(pmax - m_reg <= THR2), 1)) { mn = m_reg; alpha = 1.f; }
  else { mn = fmaxf(m_reg, pmax); alpha = __builtin_amdgcn_exp2f(m_reg - mn); m_reg = mn; }
  float mnC = 6.0f - mn;
#pragma unroll
  for (int r = 0; r < 16; ++r) p0[r] = p0[r] + mnC;
#pragma unroll
  for (int r = 0; r < 16; ++r) p1[r] = p1[r] + mnC;
#pragma unroll
  for (int r = 0; r < 16; ++r) p0[r] = __builtin_amdgcn_exp2f(p0[r]);
}
__device__ __forceinline__ void finishSM(f32x16& p0, f32x16& p1, float alpha, float& l_reg, i32x8& pa) {
#pragma unroll
  for (int r = 0; r < 16; ++r) p1[r] = __builtin_amdgcn_exp2f(p1[r]);
  float ps = 0;
#pragma unroll
  for (int r = 0; r < 16; ++r) ps += p0[r];
#pragma unroll
  for (int r = 0; r < 16; ++r) ps += p1[r];
  { auto rr = __builtin_amdgcn_permlane32_swap(__float_as_uint(ps), __float_as_uint(ps), false, false);
    ps = __uint_as_float(rr[0]) + __uint_as_float(rr[1]); }
  l_reg = l_reg * alpha + ps;
#pragma unroll
  for (int g = 0; g < 4; ++g) {
    const unsigned a = cvt_pk4_fp8(p0[4 * g], p0[4 * g + 1], p0[4 * g + 2], p0[4 * g + 3]), b = cvt_pk4_fp8(p1[4 * g], p1[4 * g + 1], p1[4 * g + 2], p1[4 * g + 3]);
    auto r = __builtin_amdgcn_permlane32_swap(a, b, false, false);
    pa[2 * g] = (int)r[0]; pa[2 * g + 1] = (int)r[1]; }
}
__device__ __forceinline__ i32x8 ld32(const char* p) { const i32x4 a = *reinterpret_cast<const i32x4*>(p), b = *reinterpret_cast<const i32x4*>(p + 16); return __builtin_shufflevector(a, b, 0, 1, 2, 3, 4, 5, 6, 7); }
#define ATT_MFMA8(P, A, B) asm volatile("v_mfma_scale_f32_32x32x64_f8f6f4 %0, %1, %2, %0, %3, %3 op_sel_hi:[0,0,0]" : "+v"(P) : "v"(A), "v"(B), "v"(one))
#define ATT_MFMA8Q(P, A, B) asm volatile("v_mfma_scale_f32_32x32x64_f8f6f4 %0, %1, %2, %0, %3, %4 op_sel_hi:[0,0,0]" : "+v"(P) : "v"(A), "v"(B), "v"(one), "v"(sq))
__device__ __forceinline__ void qkt(f32x16& p0, f32x16& p1, const char* Ks, const char* Krs, const i32x8* q8, int r32, int hi, int sq) {
  p0 = f32x16{}; p1 = f32x16{}; const int one = 0x7f7f7f7f;
  asm volatile("s_nop 1" ::: "memory");
#pragma unroll
  for (int st = 0; st < 2; ++st) {
    const i32x8 a0 = ld32(Ks + r32 * KP8 + 64 * st + 32 * hi), a1 = ld32(Ks + (32 + r32) * KP8 + 64 * st + 32 * hi);
    ATT_MFMA8Q(p0, a0, q8[st]); ATT_MFMA8Q(p1, a1, q8[st]); }
  { const i32x8 a0 = ld32(Krs + r32 * RP8 + 32 * hi), a1 = ld32(Krs + (32 + r32) * RP8 + 32 * hi);
    ATT_MFMA8Q(p0, a0, q8[2]); ATT_MFMA8Q(p1, a1, q8[2]); }
  asm volatile("s_nop 15\n\ts_nop 7" : "+v"(p0), "+v"(p1));
}
__device__ __forceinline__ void pv_d0(f32x16* o, const char* Vs, const i32x8& pa, int r32, int hi) {
  const int one = 0x7f7f7f7f;
  const i32x8 b0 = ld32(Vs + (0 * 32 + r32) * VP8 + 32 * hi), b1 = ld32(Vs + (1 * 32 + r32) * VP8 + 32 * hi), b2 = ld32(Vs + (2 * 32 + r32) * VP8 + 32 * hi), b3 = ld32(Vs + (3 * 32 + r32) * VP8 + 32 * hi);
  ATT_MFMA8(o[0], pa, b0); ATT_MFMA8(o[1], pa, b1); ATT_MFMA8(o[2], pa, b2); ATT_MFMA8(o[3], pa, b3);
}
#define ATT_MFMA8Z(P, A, B) asm volatile("v_mfma_scale_f32_32x32x64_f8f6f4 %0, %1, %2, 0, %3, %4 op_sel_hi:[0,0,0]" : "=&v"(P) : "v"(A), "v"(B), "v"(one), "v"(sq))
template <class MID>
__device__ __forceinline__ void att_step(f32x16& y0, f32x16& y1, f32x16& z0, f32x16& z1, const i32x8& paX, i32x8& paY, float& m_reg, float& alY, float& l_reg, f32x16* o,
                                         const char* Ks, const char* Krs, const char* Vs, const i32x8* q8, int r32, int hi, int one, int sq, MID&& mid) {
#define PIN16(v) asm volatile("" : "+v"(v))
#define CVT_G(g) do { const unsigned a_ = cvt_pk4_fp8_t(y0[4 * (g)], y0[4 * (g) + 1], y0[4 * (g) + 2], y0[4 * (g) + 3]), b_ = cvt_pk4_fp8_t(y1[4 * (g)], y1[4 * (g) + 1], y1[4 * (g) + 2], y1[4 * (g) + 3]); \
    auto r_ = __builtin_amdgcn_permlane32_swap(a_, b_, false, false); paY[2 * (g)] = (int)r_[0]; paY[2 * (g) + 1] = (int)r_[1]; } while (0)
  const i32x8 a0 = ld32(Ks + r32 * KP8 + 32 * hi), a1 = ld32(Ks + (32 + r32) * KP8 + 32 * hi);
#define MAX3(d, a, b, c) asm("v_max3_f32 %0, %1, %2, %3" : "=v"(d) : "v"(a), "v"(b), "v"(c))
  float pm0, pm1;
  MAX3(pm0, y0[0], y0[1], y0[2]); MAX3(pm1, y1[0], y1[1], y1[2]);
#pragma unroll
  for (int r = 3; r < 15; r += 2) { MAX3(pm0, pm0, y0[r], y0[r + 1]); MAX3(pm1, pm1, y1[r], y1[r + 1]); }
  MAX3(pm0, pm0, y0[15], y1[15]);
  float pmax; asm("v_max_f32 %0, %1, %2" : "=v"(pmax) : "v"(pm0), "v"(pm1));
  { auto rr = __builtin_amdgcn_permlane32_swap(__float_as_uint(pmax), __float_as_uint(pmax), false, false);
    float o0_ = __uint_as_float(rr[0]), o1_ = __uint_as_float(rr[1]); asm("v_max_f32 %0, %1, %2" : "=v"(pmax) : "v"(o0_), "v"(o1_)); }
#undef MAX3
  float mn;
  if (__builtin_expect(__all(pmax - m_reg <= THR2), 1)) { mn = m_reg; alY = 1.f; }
  else { mn = fmaxf(m_reg, pmax); alY = __builtin_amdgcn_exp2f(m_reg - mn); m_reg = mn; }
  float mnC = 6.0f - mn;
  asm volatile("" : "+v"(mnC), "+v"(alY), "+v"(m_reg));
  SBAR(); ATT_MFMA8Z(z0, a0, q8[0]); SBAR();
  const i32x8 c0 = ld32(Ks + r32 * KP8 + 64 + 32 * hi), c1 = ld32(Ks + (32 + r32) * KP8 + 64 + 32 * hi);
#pragma unroll
  for (int r = 0; r < 16; ++r) y0[r] = y0[r] + mnC;
  PIN16(y0); SBAR(); ATT_MFMA8Z(z1, a1, q8[0]); SBAR();
  mid();
#pragma unroll
  for (int r = 0; r < 16; ++r) y1[r] = y1[r] + mnC;
  PIN16(y1); SBAR(); ATT_MFMA8Q(z0, c0, q8[1]); SBAR();
  const i32x8 e0 = ld32(Krs + r32 * RP8 + 32 * hi), e1 = ld32(Krs + (32 + r32) * RP8 + 32 * hi);
#pragma unroll
  for (int r = 0; r < 8; ++r) y0[r] = __builtin_amdgcn_exp2f(y0[r]);
  PIN16(y0); SBAR(); ATT_MFMA8Q(z1, c1, q8[1]); SBAR();
#pragma unroll
  for (int r = 8; r < 16; ++r) y0[r] = __builtin_amdgcn_exp2f(y0[r]);
  PIN16(y0); SBAR(); ATT_MFMA8Q(z0, e0, q8[2]); SBAR();
  const i32x8 b0 = ld32(Vs + (0 * 32 + r32) * VP8 + 32 * hi), b1 = ld32(Vs + (1 * 32 + r32) * VP8 + 32 * hi);
#pragma unroll
  for (int r = 0; r < 8; ++r) y1[r] = __builtin_amdgcn_exp2f(y1[r]);
  PIN16(y1); SBAR(); ATT_MFMA8Q(z1, e1, q8[2]); SBAR();
  const i32x8 b2 = ld32(Vs + (2 * 32 + r32) * VP8 + 32 * hi), b3 = ld32(Vs + (3 * 32 + r32) * VP8 + 32 * hi);
#pragma unroll
  for (int r = 8; r < 16; ++r) y1[r] = __builtin_amdgcn_exp2f(y1[r]);
  PIN16(y1); SBAR(); ATT_MFMA8(o[0], paX, b0); SBAR();
  float ps = 0;
#pragma unroll
  for (int r = 0; r < 16; ++r) ps += y0[r];
  asm volatile("" : "+v"(ps)); SBAR(); ATT_MFMA8(o[1], paX, b1); SBAR();
#pragma unroll
  for (int r = 0; r < 16; ++r) ps += y1[r];
  { auto rr = __builtin_amdgcn_permlane32_swap(__float_as_uint(ps), __float_as_uint(ps), false, false);
    ps = __uint_as_float(rr[0]) + __uint_as_float(rr[1]); }
  l_reg = l_reg * alY + ps;
  asm volatile("" : "+v"(l_reg)); SBAR(); ATT_MFMA8(o[2], paX, b2); SBAR();
  CVT_G(0); CVT_G(1);
  asm volatile("" : "+v"(paY)); SBAR(); ATT_MFMA8(o[3], paX, b3); SBAR();
  CVT_G(2); CVT_G(3);
  asm volatile("" : "+v"(paY));
#undef PIN16
#undef CVT_G
}
__device__ __forceinline__ void attn_unit(const unsigned char* __restrict__ Q, const unsigned char* __restrict__ KN, const unsigned char* __restrict__ VT, const unsigned char* __restrict__ KR, bf16_t* __restrict__ O, int b, int h, int qb, char* lds) {
  int tid = threadIdx.x; asm volatile("" : "+v"(tid));
  const int wid = tid >> 6, lane = tid & 63, r32 = lane & 31, hi = lane >> 5;
  char* V_lds = lds + OFF_V; char* K_lds = lds + OFF_K; char* KR_lds = lds + OFF_KR;
  float* wsl = (float*)(lds + OFF_WS) + wid * 64; float* li_l = wsl; float* al_l = wsl + 32;
  float m_reg = -1e30f, l_reg = 0; f32x16 o[4] = {}; i32x8 qr[3];
  const long qrow = (long)b * 4096 + qb * 256 + wid * QBLK + r32;
  { const unsigned char* Qp = Q + qrow * LDQ;
    const i32x4 a0 = *reinterpret_cast<const i32x4*>(Qp + h * 128 + 32 * hi), a1 = *reinterpret_cast<const i32x4*>(Qp + h * 128 + 32 * hi + 16);
    const i32x4 b0 = *reinterpret_cast<const i32x4*>(Qp + h * 128 + 64 + 32 * hi), b1 = *reinterpret_cast<const i32x4*>(Qp + h * 128 + 64 + 32 * hi + 16);
    const i32x4 c0 = *reinterpret_cast<const i32x4*>(Qp + 2048 + h * 64 + 32 * hi), c1 = *reinterpret_cast<const i32x4*>(Qp + 2048 + h * 64 + 32 * hi + 16);
    qr[0] = __builtin_shufflevector(a0, a1, 0, 1, 2, 3, 4, 5, 6, 7); qr[1] = __builtin_shufflevector(b0, b1, 0, 1, 2, 3, 4, 5, 6, 7); qr[2] = __builtin_shufflevector(c0, c1, 0, 1, 2, 3, 4, 5, 6, 7); }
  const int vr_ = tid >> 2, vc_ = (tid & 3) * 16;
  const int kr_ = tid >> 3, kc_ = (tid & 7) * 16;
  const int rr_ = (tid >> 2) & 63, rc_ = (tid & 3) * 16;
  const unsigned char* Vh = VT + (size_t)(h * 128) * LDVT; const unsigned char* Kh = KN + h * 128;
  struct { i32x4 vs0, kn0, kr0; } sr_[1];
#define TROW(jt) ((long)((jt) < 64 ? b * 4096 + (jt) * 64 : T + b * 256 + ((jt) - 64) * 64))
#define SLOAD(i, jt) do { const long _r0 = TROW(jt); \
    sr_[i].vs0 = *reinterpret_cast<const i32x4*>(&Vh[(size_t)vr_ * LDVT + _r0 + vc_]); \
    sr_[i].kn0 = *reinterpret_cast<const i32x4*>(&Kh[(_r0 + kr_) * LDKN + kc_]); \
    if (wid < 4) sr_[i].kr0 = *reinterpret_cast<const i32x4*>(&KR[(_r0 + rr_) * LDKR + rc_]); } while (0)
#define SWRITE(bb, i) do { *(i32x4*)(V_lds + (bb) * SHM_V + vr_ * VP8 + vc_) = sr_[i].vs0;   \
    *(i32x4*)(K_lds + (bb) * SHM_K + kr_ * KP8 + kc_) = sr_[i].kn0;                       \
    if (wid < 4) *(i32x4*)(KR_lds + (bb) * SHM_KR + rr_ * RP8 + rc_) = sr_[i].kr0; } while (0)
#define SWAIT() asm volatile("s_waitcnt vmcnt(0)" ::: "memory")
#define RESC(a) do { if (__any((a) < 1.f)) { if (hi == 0) al_l[r32] = (a); asm volatile("s_nop 15\n\ts_nop 15\n\ts_nop 15\n\ts_nop 15\n\ts_nop 15\n\ts_nop 15\n\ts_waitcnt lgkmcnt(0)" ::: "memory"); \
    _Pragma("unroll") for (int d = 0; d < 4; ++d) _Pragma("unroll") for (int r = 0; r < 16; ++r) o[d][r] *= al_l[crow(r, hi)]; } } while (0)
  f32x16 pA0, pA1, pB0, pB1; float mnA, mnB, alA, alB; constexpr int NT = 68;
  int one = 0x7f7f7f7f; asm volatile("" : "+v"(one)); int sq = 0x7c7c7c7c; asm volatile("" : "+v"(sq));
  { struct { i32x4 vs0, kn0, kr0; } pr_[3];
#pragma unroll
    for (int t = 0; t < 3; ++t) { const long _r0 = TROW(t);
      pr_[t].vs0 = *reinterpret_cast<const i32x4*>(&Vh[(size_t)vr_ * LDVT + _r0 + vc_]); pr_[t].kn0 = *reinterpret_cast<const i32x4*>(&Kh[(_r0 + kr_) * LDKN + kc_]);
      if (wid < 4) pr_[t].kr0 = *reinterpret_cast<const i32x4*>(&KR[(_r0 + rr_) * LDKR + rc_]); }
#pragma unroll
    for (int t = 0; t < 3; ++t) { *(i32x4*)(V_lds + t * SHM_V + vr_ * VP8 + vc_) = pr_[t].vs0; *(i32x4*)(K_lds + t * SHM_K + kr_ * KP8 + kc_) = pr_[t].kn0;
      if (wid < 4) *(i32x4*)(KR_lds + t * SHM_KR + rr_ * RP8 + rc_) = pr_[t].kr0; } }
  __syncthreads();
  SLOAD(0, 3);
  i32x8 pa0, pa1;
  qkt(pA0, pA1, K_lds, KR_lds, qr, r32, hi, sq); partialSM(pA0, pA1, m_reg, mnA, alA); finishSM(pA0, pA1, alA, l_reg, pa0);
  qkt(pB0, pB1, K_lds + SHM_K, KR_lds + SHM_KR, qr, r32, hi, sq);
#define STAGE(s_) [&]() { if ((s_) + 3 < NT) { SWAIT(); SWRITE(((s_) + 3) & 3, 0); } if ((s_) + 4 < NT) SLOAD(0, (s_) + 4); }
  for (int t = 0; t + 2 < NT; t += 2) {
    att_step(pB0, pB1, pA0, pA1, pa0, pa1, m_reg, alB, l_reg, o, K_lds + ((t + 2) & 3) * SHM_K, KR_lds + ((t + 2) & 3) * SHM_KR, V_lds + (t & 3) * SHM_V, qr, r32, hi, one, sq, STAGE(t));
    RESC(alB); __syncthreads();
    att_step(pA0, pA1, pB0, pB1, pa1, pa0, m_reg, alA, l_reg, o, K_lds + ((t + 3) & 3) * SHM_K, KR_lds + ((t + 3) & 3) * SHM_KR, V_lds + ((t + 1) & 3) * SHM_V, qr, r32, hi, one, sq, STAGE(t + 1));
    RESC(alA); __syncthreads();
  }
#undef STAGE
  pv_d0(o, V_lds + ((NT - 2) & 3) * SHM_V, pa0, r32, hi); SBAR();
  asm volatile("s_nop 15\n\ts_nop 7" : "+v"(pB0), "+v"(pB1));
  partialSM(pB0, pB1, m_reg, mnB, alB); finishSM(pB0, pB1, alB, l_reg, pa1); SBAR();
  RESC(alB);
  pv_d0(o, V_lds + ((NT - 1) & 3) * SHM_V, pa1, r32, hi);
  asm volatile("s_nop 15\n\ts_nop 15" ::: "memory");
  if (hi == 0) li_l[r32] = l_reg; asm volatile("s_waitcnt lgkmcnt(0)" ::: "memory");
  float rli[16];
#pragma unroll
  for (int r = 0; r < 16; ++r) rli[r] = __builtin_amdgcn_rcpf(li_l[crow(r, hi)]);
  unsigned char* Ow8 = (unsigned char*)O + ((long)b * 4096 + qb * 256 + wid * QBLK) * LDO + h * 128;
#pragma unroll
  for (int r = 0; r < 16; ++r) { int orow = crow(r, hi);
#pragma unroll
    for (int d0 = 0; d0 < 4; ++d0) { const float v = o[d0][r] * rli[r] * 64.0f; Ow8[(long)orow * LDO + d0 * 32 + r32] = (unsigned char)__builtin_amdgcn_cvt_pk_fp8_f32(v, v, 0, false); } }
  __syncthreads();
#undef TROW
#undef SLOAD
#undef SWRITE
#undef SWAIT
#undef RESC
}
}

struct Args { const float* in[27]; float* out; unsigned char* ws; int ph_lo, ph_hi; };
constexpr int NPHASE = 12;

template <class CM>
__device__ __forceinline__ void cvt_item(const CM& cm, int ldw, const float* kscale, bf16_t* WT, int ldt, LAS unsigned char* scr, int k0, int n0, int lane) {
    const int kq = lane >> 4, nq = lane & 15, kb = k0 + 16 * kq;
    const float* p0 = cm.colptr(n0 + 4 * nq); const float* p1 = cm.colptr(n0 + 4 * nq + 1); const float* p2 = cm.colptr(n0 + 4 * nq + 2); const float* p3 = cm.colptr(n0 + 4 * nq + 3);
    const bool vec = p0 && p1 == p0 + 1 && p2 == p0 + 2 && p3 == p0 + 3 && (((uintptr_t)p0) & 15) == 0;
    f32x4 v[16];
    if (vec) {
#pragma unroll
        for (int i = 0; i < 16; ++i) v[i] = *(const f32x4*)(p0 + (size_t)(kb + i) * ldw);
    } else {
#pragma unroll
        for (int i = 0; i < 16; ++i) { const size_t o = (size_t)(kb + i) * ldw; v[i] = (f32x4){p0 ? p0[o] : 0.f, p1 ? p1[o] : 0.f, p2 ? p2[o] : 0.f, p3 ? p3[o] : 0.f}; }
    }
    if (kscale) {
#pragma unroll
        for (int i = 0; i < 16; ++i) v[i] = v[i] * kscale[kb + i];
    }
#pragma unroll
    for (int j = 0; j < 4; ++j) {
        u32x4 lo, hi;
        lo.x = cvt_pk_bf16(v[0][j], v[1][j]); lo.y = cvt_pk_bf16(v[2][j], v[3][j]); lo.z = cvt_pk_bf16(v[4][j], v[5][j]); lo.w = cvt_pk_bf16(v[6][j], v[7][j]);
        hi.x = cvt_pk_bf16(v[8][j], v[9][j]); hi.y = cvt_pk_bf16(v[10][j], v[11][j]); hi.z = cvt_pk_bf16(v[12][j], v[13][j]); hi.w = cvt_pk_bf16(v[14][j], v[15][j]);
        LAS unsigned char* d = scr + (4 * nq + j) * 144 + kq * 32;
        *(LAS u32x4*)d = lo; *(LAS u32x4*)(d + 16) = hi;
    }
    LDS_WAIT(); asm volatile("" ::: "memory");
#pragma unroll
    for (int it = 0; it < 8; ++it) { const int r = 8 * it + (lane >> 3), c = lane & 7;
        *(u32x4*)(WT + (size_t)(n0 + r) * ldt + k0 + 8 * c) = *(const LAS u32x4*)(scr + r * 144 + c * 16); }
    LDS_WAIT(); asm volatile("" ::: "memory");
}
template <class CM>
__device__ __forceinline__ void cvt_item8(const CM& cm, int ldw, float scale, unsigned char* WT8, int ldt, LAS unsigned char* scr, int k0, int n0, int lane, const float* kscale = nullptr) {
    const int kq = lane >> 4, nq = lane & 15, kb = k0 + 16 * kq;
    const float* p0 = cm.colptr(n0 + 4 * nq); const float* p1 = cm.colptr(n0 + 4 * nq + 1); const float* p2 = cm.colptr(n0 + 4 * nq + 2); const float* p3 = cm.colptr(n0 + 4 * nq + 3);
    const bool vec = p0 && p1 == p0 + 1 && p2 == p0 + 2 && p3 == p0 + 3 && (((uintptr_t)p0) & 15) == 0;
    f32x4 v[16];
    if (vec) {
#pragma unroll
        for (int i = 0; i < 16; ++i) v[i] = *(const f32x4*)(p0 + (size_t)(kb + i) * ldw);
    } else {
#pragma unroll
        for (int i = 0; i < 16; ++i) { const size_t o = (size_t)(kb + i) * ldw; v[i] = (f32x4){p0 ? p0[o] : 0.f, p1 ? p1[o] : 0.f, p2 ? p2[o] : 0.f, p3 ? p3[o] : 0.f}; }
    }
    if (kscale) {
#pragma unroll
        for (int i = 0; i < 16; ++i) v[i] = v[i] * kscale[kb + i];
    }
#pragma unroll
    for (int j = 0; j < 4; ++j) {
        u32x4 w;
        w.x = cvt_pk4_fp8(v[0][j] * scale, v[1][j] * scale, v[2][j] * scale, v[3][j] * scale); w.y = cvt_pk4_fp8(v[4][j] * scale, v[5][j] * scale, v[6][j] * scale, v[7][j] * scale);
        w.z = cvt_pk4_fp8(v[8][j] * scale, v[9][j] * scale, v[10][j] * scale, v[11][j] * scale); w.w = cvt_pk4_fp8(v[12][j] * scale, v[13][j] * scale, v[14][j] * scale, v[15][j] * scale);
        *(LAS u32x4*)(scr + (4 * nq + j) * 80 + kq * 16) = w;
    }
    LDS_WAIT(); asm volatile("" ::: "memory");
#pragma unroll
    for (int it = 0; it < 4; ++it) { const int r = 16 * it + (lane >> 2), c = lane & 3;
        *(u32x4*)(WT8 + (size_t)(n0 + r) * ldt + k0 + 16 * c) = *(const LAS u32x4*)(scr + r * 80 + c * 16); }
    LDS_WAIT(); asm volatile("" ::: "memory");
}
__device__ __forceinline__ int rope_src(int s) { return (s >> 5) * 32 + (s & 1) * 16 + ((s & 31) >> 1); }
struct CM_Id { const float* W; __device__ __forceinline__ const float* colptr(int n) const { return W + n; } };
struct CM_W1 { const float* W;
    __device__ __forceinline__ const float* colptr(int n) const { if (n < 2048) return W + n; if (n < 6144) return W + n + 64; if (n < 6208) return W + 2048 + rope_src(n - 6144); return nullptr; } };
struct CM_Q { const float* W;
    __device__ __forceinline__ const float* colptr(int n) const { if (n < 2048) return W + (n >> 7) * 192 + (n & 127); const int r = n - 2048; return W + (r >> 6) * 192 + 128 + rope_src(r & 63); } };
struct CM_KV { const float* W;
    __device__ __forceinline__ const float* colptr(int n) const { const int v = n >> 11, r = n & 2047; return W + (r >> 7) * 256 + v * 128 + (r & 127); } };
struct CM_GU { const float* Wg; const float* Wu;
    __device__ __forceinline__ const float* colptr(int n) const { const int q = n >> 3, j = n & 7; return j < 4 ? Wg + 4 * q + j : Wu + 4 * q + j - 4; } };

__device__ __forceinline__ void phase0(const Args& a, LAS unsigned char* lds) {
    const int tid = threadIdx.x, lane = tid & 63, wave = tid >> 6, G = gridDim.x;
    const int gtid = blockIdx.x * 512 + tid, NTH = G * 512, gw = blockIdx.x * 8 + wave, NGW = G * 8;
    unsigned char* ws = a.ws;
    LAS float* S = (LAS float*)lds;
    LAS float* RED = (LAS float*)(lds + 40960);
    for (int i = tid; i < 5 * 2048; i += 512) { const int r = i >> 11, k = i & 2047; const float v = r < 4 ? a.in[1][r * 2048 + k] : a.in[3][k]; S[i] = v * sigmoidf_(v); }
    __syncthreads();
    float* MOD = (float*)(ws + WS_MOD);
    for (int item = blockIdx.x; item < NMODC / 64; item += G) {
        const int cg = tid & 15, ks = tid >> 4, n = item * 64 + 4 * cg;
        f32x4 acc[5];
#pragma unroll
        for (int r = 0; r < 5; ++r) acc[r] = (f32x4){0.f, 0.f, 0.f, 0.f};
        const float* wp = a.in[4] + (size_t)(ks * 64) * NMODC + n;
#pragma unroll 16
        for (int kk = 0; kk < 64; ++kk) { const f32x4 w = *(const f32x4*)(wp + (size_t)kk * NMODC); const int k = ks * 64 + kk;
#pragma unroll
            for (int r = 0; r < 5; ++r) acc[r] += w * S[r * 2048 + k]; }
#pragma unroll
        for (int r = 0; r < 5; ++r)
#pragma unroll
            for (int j = 0; j < 4; ++j) RED[(ks * 5 + r) * 64 + 4 * cg + j] = acc[r][j];
        __syncthreads();
        if (tid < 320) { const int r = tid >> 6, cn = tid & 63; float s = 0.f;
            for (int q = 0; q < 32; ++q) s += RED[(q * 5 + r) * 64 + cn];
            MOD[r * NMODC + item * 64 + cn] = s + a.in[5][item * 64 + cn]; }
        __syncthreads();
    }
    __syncthreads();
    if (gtid < 64 * 16) { const int pos = gtid >> 4, f = gtid & 15; const float freq = 1.0f / powf(10000.0f, (float)f / 16.0f); const float ang = (float)pos * freq;
        float* cs = (float*)(ws + WS_CS); cs[gtid * 2] = cosf(ang); cs[gtid * 2 + 1] = sinf(ang); }
    { bf16_t* PW = (bf16_t*)(ws + WS_PW); const float* pw = a.in[11];
      for (int i = gtid; i < 4 * 256 * 256 / 4; i += NTH) { const f32x4 v = *(const f32x4*)(pw + 4 * (size_t)i); u32x2 o; o.x = pk2(v[0], v[1]); o.y = pk2(v[2], v[3]); *(u32x2*)(PW + 4 * (size_t)i) = o; }
      bf16_t* WRH = (bf16_t*)(ws + WS_WRH); bf16_t* WRL = (bf16_t*)(ws + WS_WRL);
      for (int i = gtid; i < 64 * 2048; i += NTH) { const int n = i >> 11, k = i & 2047; float v = 0.f;
          if (n < 32) v = a.in[22][k * 32 + n]; else if (n < 36) v = a.in[20][k * 4 + (n - 32)];
          const unsigned h = f2bf(v); const float lo = v - __uint_as_float(h << 16); WRH[i] = (bf16_t)h; WRL[i] = (bf16_t)f2bf(lo); } }
    LAS unsigned char* scr = lds + wave * 16384;
    constexpr int I0 = 32 * (N1 / 64), I1 = 8 * (NQ / 64), I2 = 8 * (NKV / 64), I3 = 16 * 32, I4 = 32 * 32, I5 = 32 * 32;
    constexpr int NIT = I0 + I1 + I2 + I3 + I4 + I5;
    (void)I1; (void)I2; (void)I3; (void)I4; (void)I5; (void)NIT;
    for (int it = gw; it < I0; it += NGW) { const int nb = N1 / 64; cvt_item8(CM_W1{a.in[10]}, 6208, 32.0f, (unsigned char*)(ws + WS_W1T), 2048, scr, 64 * (it / nb), 64 * (it % nb), lane); }
}
__device__ __forceinline__ void late_weights(const Args& a, LAS unsigned char* lds, int pi, int np) {
    const int tid = threadIdx.x, lane = tid & 63, wave = tid >> 6; unsigned char* ws = a.ws;
    LAS unsigned char* scr = lds + wave * 16384;
    constexpr int I1 = 8 * (NQ / 64), I2 = 8 * (NKV / 64), I3 = 16 * 32, I4 = 32 * 32, I5 = 32 * 32;
    for (int it = pi * 8 + wave; it < I1 + I2 + I3 + I4 + I5; it += np * 8) {
        int r = it;
        if (r < I3) { cvt_item(CM_Id{a.in[13]}, DM, a.in[12], (bf16_t*)(ws + WS_BPT), 1024, scr, 64 * (r / 32), 64 * (r % 32), lane); continue; } r -= I3;
        if (r < I1) { const int nb = NQ / 64; cvt_item8(CM_Q{a.in[15]}, NQ, 16.0f, (unsigned char*)(ws + WS_WQT), 512, scr, 64 * (r / nb), 64 * (r % nb), lane, a.in[14]); continue; } r -= I1;
        if (r < I2) { const int nb = NKV / 64; cvt_item8(CM_KV{a.in[17]}, NKV, 16.0f, (unsigned char*)(ws + WS_WKVT), 512, scr, 64 * (r / nb), 64 * (r % nb), lane, a.in[16]); continue; } r -= I2;
        if (r < I4) { cvt_item8(CM_Id{a.in[18]}, DM, 32.0f, (unsigned char*)(ws + WS_WOT), 2048, scr, 64 * (r / 32), 64 * (r % 32), lane); continue; } r -= I4;
        cvt_item8(CM_Id{a.in[19]}, DM, 32.0f, (unsigned char*)(ws + WS_WOUTT), 2048, scr, 64 * (r / 32), 64 * (r % 32), lane);
    }
}
__device__ __forceinline__ void phase1(const Args& a, LAS unsigned char* lds) {
    const int tid = threadIdx.x, lane = tid & 63, wave = tid >> 6, G = gridDim.x, gw = blockIdx.x * 8 + wave, NGW = G * 8;
    unsigned char* ws = a.ws; const float* MOD = (const float*)(ws + WS_MOD); const float* gpre = a.in[6]; bf16_t* H = (bf16_t*)(ws + WS_H);
    for (int m = gw; m < TA; m += NGW) {
        const float* xrow; const float* sh;
        if (m < T) { xrow = a.in[0] + (size_t)m * DM; sh = MOD + (m >> 12) * NMODC; } else { xrow = a.in[2] + (size_t)(m - T) * DM; sh = MOD + 4 * NMODC; }
        const float* sc = sh + 2048;
        f32x4 v[8]; float s = 0.f;
#pragma unroll
        for (int j = 0; j < 8; ++j) { v[j] = ((const f32x4*)xrow)[lane + 64 * j]; s += pg8::sq4(v[j]); }
        const float r = rsqrtf(wave_sum(s) * (1.0f / DM) + EPS);
        unsigned* o4 = (unsigned*)((unsigned char*)H + (size_t)m * DM) + lane;
#pragma unroll
        for (int j = 0; j < 8; ++j) { const f32x4 g = ((const f32x4*)gpre)[lane + 64 * j], c = ((const f32x4*)sc)[lane + 64 * j], h = ((const f32x4*)sh)[lane + 64 * j];
            const f32x4 y = v[j] * r * g * (c + 1.0f) + h; o4[64 * j] = cvt_pk4_fp8(y[0], y[1], y[2], y[3]); }
    }
    __syncthreads();
}
template <int HW>
__device__ __forceinline__ void pool_diff_item(const bf16_t* U, bf16_t* P, int t, int ch) {
    const int l = t & 4095, base = t - l;
    f32x4 s0 = {0.f, 0.f, 0.f, 0.f}, s1 = s0; u32x4 w[2 * HW];
#pragma unroll
    for (int k = 0; k < 2 * HW; ++k) { int tt = l - HW + k; tt = tt < 0 ? 0 : (tt > 4095 ? 4095 : tt); w[k] = *(const u32x4*)(U + (size_t)(base + tt) * 1024 + ch * 8); }
#pragma unroll
    for (int k = 0; k < 2 * HW; ++k) { const int tt = l - HW + k; const float v = (tt >= 0 && tt < 4096) ? 1.f : 0.f; f32x4 x0, x1; pg8::unpack8(w[k], x0, x1); s0 += x0 * v; s1 += x1 * v; }
    const int lo = l - HW < 0 ? 0 : l - HW, hi = l + HW > 4096 ? 4096 : l + HW; const float inv = 1.0f / (float)(hi - lo);
    f32x4 u0, u1; pg8::unpack8(w[HW], u0, u1);
    *(u32x4*)(P + (size_t)t * 1024 + ch * 8) = pg8::pack8(s0 * inv - u0, s1 * inv - u1);
}
__device__ __forceinline__ void pool_diff_pass(const Args& a) {
    const int gtid = blockIdx.x * 512 + opaque_tid(), NTH = gridDim.x * 512;
    const bf16_t* U = (const bf16_t*)(a.ws + WS_POOLIN); bf16_t* P = (bf16_t*)(a.ws + WS_POOLED);
    for (int item = gtid; item < T * 128; item += NTH) {
        const int c = item & 31, t = (item >> 5) & (T - 1), g = item >> 19, ch = g * 32 + c;
        if (g == 0) pool_diff_item<1>(U, P, t, ch); else if (g == 1) pool_diff_item<2>(U, P, t, ch); else if (g == 2) pool_diff_item<4>(U, P, t, ch); else pool_diff_item<8>(U, P, t, ch);
    }
}
__device__ __forceinline__ void kr_rope_pass(const Args& a) {
    const int gtid = blockIdx.x * 512 + opaque_tid(), NTH = gridDim.x * 512;
    const bf16_t* K2 = (const bf16_t*)(a.ws + WS_KR2); bf16_t* KR = (bf16_t*)(a.ws + WS_KR); const float* cs = (const float*)(a.ws + WS_CS);
    for (int item = gtid; item < TA * 8; item += NTH) { const int row = item >> 3, ch = item & 7;
        f32x4 v0, v1; pg8::unpack8(*(const u32x4*)(K2 + (size_t)row * 256 + ch * 8), v0, v1);
        if (row < T) { const int l = row & 4095, pos = (ch >> 2) ? (l & 63) : (l >> 6); pg8::rope8(v0, v1, cs + (pos * 16 + 4 * (ch & 3)) * 2); }
        u32x2 w8; w8.x = cvt_pk4_fp8(v0[0], v0[1], v0[2], v0[3]); w8.y = cvt_pk4_fp8(v1[0], v1[1], v1[2], v1[3]); *(u32x2*)((unsigned char*)KR + (size_t)row * 64 + ch * 8) = w8; }
}
template <int WHICH>
__device__ __forceinline__ void moe_cvt(const Args& a, LAS unsigned char* lds, int pi, int np) {
    const int tid = threadIdx.x, lane = tid & 63, wave = __builtin_amdgcn_readfirstlane(tid >> 6); unsigned char* ws = a.ws;
    LAS unsigned char* scr = lds + wave * 16384; const int gw = pi * 8 + wave, NGW = np * 8;
    constexpr int IGU = 32 * 16, IDN = 8 * 32;
    for (int it = (WHICH ? NEXP * IGU : 0) + gw; it < (WHICH ? NEXP * (IGU + IDN) : NEXP * IGU); it += NGW) {
        if (it < NEXP * IGU) { const int e = it / IGU, r = it % IGU;
            cvt_item8(CM_GU{a.in[24] + (size_t)e * DM * DE, a.in[25] + (size_t)e * DM * DE}, DE, 32.0f, (unsigned char*)(ws + WS_WGU) + (size_t)e * 1024 * DM, DM, scr, 64 * (r / 16), 64 * (r % 16), lane); }
        else { const int q = it - NEXP * IGU, e = q / IDN, r = q % IDN;
            cvt_item8(CM_Id{a.in[26] + (size_t)e * DE * DM}, DM, 16.0f, (unsigned char*)(ws + WS_WD) + (size_t)e * DM * DE, DE, scr, 64 * (r / 32), 64 * (r % 32), lane); } }
}
__device__ __forceinline__ void phase7(const Args& a, LAS unsigned char* lds) {
    const int tid = threadIdx.x, lane = tid & 63, wave = __builtin_amdgcn_readfirstlane(tid >> 6), G = gridDim.x;
    unsigned char* ws = a.ws;
    constexpr int PITCH = 520;
    LAS bf16_t* THI = (LAS bf16_t*)lds; LAS bf16_t* TLO = THI + 32 * PITCH;
    LAS float* RED = (LAS float*)lds;
    LAS float* LOG = (LAS float*)(lds + 66560);
    LAS unsigned* cntl = (LAS unsigned*)(lds + MISC_OFF + 256);
    if (tid < 32) cntl[tid] = 0u;
    __syncthreads();
    const float* x = a.in[0]; bf16_t* X1B = (bf16_t*)(ws + WS_X1B); const float* MOD = (const float*)(ws + WS_MOD);
    const bf16_t* YX = (const bf16_t*)(ws + WS_YX); bf16_t* H2 = (bf16_t*)(ws + WS_H2);
    const bf16_t* WRH = (const bf16_t*)(ws + WS_WRH); const bf16_t* WRL = (const bf16_t*)(ws + WS_WRL);
    f32x2* TW = (f32x2*)(ws + WS_TW);
    LAS i32x4* tis = (LAS i32x4*)(lds + 73728);
    LAS unsigned* basel = (LAS unsigned*)(lds + MISC_OFF + 384);
    int tl = -1;
    for (int tile = blockIdx.x; tile < T / 32; tile += G) {
        ++tl;
        float r2[4];
#pragma unroll
        for (int rr = 0; rr < 4; ++rr) {
            const int t = tile * 32 + wave * 4 + rr; const float* mod = MOD + (t >> 12) * NMODC;
            f32x4 yv[8]; float sp = 0.f;
#pragma unroll
            for (int j = 0; j < 8; ++j) { const u32x2 yw = ((const u32x2*)(YX + (size_t)t * DM))[lane + 64 * j]; yv[j] = (f32x4){bflo(yw.x), bfhi(yw.x), bflo(yw.y), bfhi(yw.y)}; sp += pg8::sq4(yv[j]); }
            const float r1 = rsqrtf(wave_sum(sp) * (1.0f / DM) + EPS);
            float s1 = 0.f;
#pragma unroll
            for (int j = 0; j < 8; ++j) { const int k4 = lane + 64 * j;
                const f32x4 y = yv[j];
                const f32x4 xv = ((const f32x4*)(x + (size_t)t * DM))[k4], gp = ((const f32x4*)a.in[7])[k4], g1 = ((const f32x4*)(mod + 4096))[k4];
                const f32x4 x1 = xv + g1 * (y * r1 * gp); ((u32x2*)(X1B + (size_t)t * DM))[k4] = (u32x2){pk2(x1[0], x1[1]), pk2(x1[2], x1[3])}; s1 += pg8::sq4(x1); }
            r2[rr] = rsqrtf(wave_sum(s1) * (1.0f / DM) + EPS);
        }
        f32x16 C0 = {}, C1 = {};
        for (int c = 0; c < 4; ++c) {
            if (c > 0) __syncthreads();
#pragma unroll
            for (int rr = 0; rr < 4; ++rr) {
                const int t = tile * 32 + wave * 4 + rr; const float* mod = MOD + (t >> 12) * NMODC;
#pragma unroll
                for (int jj = 0; jj < 2; ++jj) { const int k4 = lane + 64 * (2 * c + jj);
                    const u32x2 xw = ((const u32x2*)(X1B + (size_t)t * DM))[k4]; const f32x4 x1 = (f32x4){bflo(xw.x), bfhi(xw.x), bflo(xw.y), bfhi(xw.y)}, gn = ((const f32x4*)a.in[8])[k4], sc2 = ((const f32x4*)(mod + 8192))[k4], sh2 = ((const f32x4*)(mod + 6144))[k4];
                    const f32x4 h = x1 * r2[rr] * gn * (sc2 + 1.0f) + sh2;
                    u32x2 wh, wl; { const unsigned h0 = f2bf(h[0]), h1 = f2bf(h[1]), h2 = f2bf(h[2]), h3 = f2bf(h[3]);
                        wh.x = h0 | (h1 << 16); wh.y = h2 | (h3 << 16);
                        wl.x = pk2(h[0] - __uint_as_float(h0 << 16), h[1] - __uint_as_float(h1 << 16)); wl.y = pk2(h[2] - __uint_as_float(h2 << 16), h[3] - __uint_as_float(h3 << 16)); }
                    ((unsigned*)((unsigned char*)H2 + (size_t)t * DM))[k4] = cvt_pk4_fp8(h[0], h[1], h[2], h[3]);
                    *(LAS u32x2*)(THI + (wave * 4 + rr) * PITCH + 4 * lane + 256 * jj) = wh; *(LAS u32x2*)(TLO + (wave * 4 + rr) * PITCH + 4 * lane + 256 * jj) = wl; }
            }
            __syncthreads();
#pragma unroll
            for (int ks = 0; ks < 4; ++ks) { const int kk = (wave * 4 + ks) * 16 + (lane >> 5) * 8, kg = c * 512 + kk;
                const bf16x8 Bh = *(const LAS bf16x8*)(THI + (lane & 31) * PITCH + kk), Bl = *(const LAS bf16x8*)(TLO + (lane & 31) * PITCH + kk);
                const bf16x8 A0h = *(const bf16x8*)(WRH + (size_t)(lane & 31) * DM + kg), A0l = *(const bf16x8*)(WRL + (size_t)(lane & 31) * DM + kg);
                const bf16x8 A1h = *(const bf16x8*)(WRH + (size_t)(32 + (lane & 31)) * DM + kg), A1l = *(const bf16x8*)(WRL + (size_t)(32 + (lane & 31)) * DM + kg);
                C0 = __builtin_amdgcn_mfma_f32_32x32x16_bf16(A0h, Bh, C0, 0, 0, 0); C0 = __builtin_amdgcn_mfma_f32_32x32x16_bf16(A0h, Bl, C0, 0, 0, 0); C0 = __builtin_amdgcn_mfma_f32_32x32x16_bf16(A0l, Bh, C0, 0, 0, 0);
                C1 = __builtin_amdgcn_mfma_f32_32x32x16_bf16(A1h, Bh, C1, 0, 0, 0); C1 = __builtin_amdgcn_mfma_f32_32x32x16_bf16(A1h, Bl, C1, 0, 0, 0); C1 = __builtin_amdgcn_mfma_f32_32x32x16_bf16(A1l, Bh, C1, 0, 0, 0); }
        }
        __syncthreads();
        { const int hi = lane >> 5, j = lane & 31;
#pragma unroll
          for (int r = 0; r < 16; ++r) { const int e = att::crow(r, hi); RED[(wave * 64 + e) * 32 + j] = C0[r]; RED[(wave * 64 + 32 + e) * 32 + j] = C1[r]; } }
        __syncthreads();
        for (int i = tid; i < 36 * 32; i += 512) { const int e = i >> 5, j = i & 31; float s = 0.f;
#pragma unroll
            for (int w = 0; w < 8; ++w) s += RED[(w * 64 + e) * 32 + j];
            LOG[i] = s + (e < 32 ? a.in[23][e] : a.in[21][e - 32]); }
        __syncthreads();
        if (tid < 32) { const int j = tid, t = tile * 32 + j;
            float gm = LOG[32 * 32 + j]; int gi = 0;
#pragma unroll
            for (int q = 1; q < 4; ++q) { const float v = LOG[(32 + q) * 32 + j]; if (v > gm) { gm = v; gi = q; } }
            float gs = 0.f;
#pragma unroll
            for (int q = 0; q < 4; ++q) gs += __expf(LOG[(32 + q) * 32 + j] - gm);
            const float pg = 1.0f / gs;
            float b1 = LOG[(gi * 8) * 32 + j]; int i1 = 0;
#pragma unroll
            for (int q = 1; q < 8; ++q) { const float v = LOG[(gi * 8 + q) * 32 + j]; if (v > b1) { b1 = v; i1 = q; } }
            float b2 = -3.0e38f; int i2 = 0;
#pragma unroll
            for (int q = 0; q < 8; ++q) { const float v = LOG[(gi * 8 + q) * 32 + j]; if (q != i1 && v > b2) { b2 = v; i2 = q; } }
            const float p1 = __expf(b2 - b1), w0 = pg / (1.0f + p1), w1 = pg * p1 / (1.0f + p1);
            const int e0 = gi * 8 + i1, e1 = gi * 8 + i2;
            const unsigned lp0 = __hip_atomic_fetch_add(&cntl[e0], 1u, __ATOMIC_RELAXED, __HIP_MEMORY_SCOPE_WORKGROUP), lp1 = __hip_atomic_fetch_add(&cntl[e1], 1u, __ATOMIC_RELAXED, __HIP_MEMORY_SCOPE_WORKGROUP);
            tis[tl * 32 + j] = (i32x4){e0, e1, (int)lp0, (int)lp1}; TW[t] = (f32x2){w0, w1}; }
        __syncthreads();
    }
    if (tid < 32) { const unsigned n = cntl[tid]; unsigned base = 0u;
        if (n) base = __hip_atomic_fetch_add((unsigned*)(ws + WS_CTL) + CW_CNT + 64 * tid, n, RLX_AGENT);
        basel[tid] = base; }
    __syncthreads();
    { int* RM = (int*)(ws + WS_ROWMAP2);
      for (int i = tid; i < (tl + 1) * 32; i += 512) { const i32x4 ti = tis[i]; const int t = ((int)blockIdx.x + (i >> 5) * G) * 32 + (i & 31);
          RM[ti.x * RM_CAP + (int)basel[ti.x] + ti.z] = 2 * t; RM[ti.y * RM_CAP + (int)basel[ti.y] + ti.w] = 2 * t + 1; } }
    __syncthreads();
}
__device__ __forceinline__ void build_cum(const Args& a, LAS int* cum) {
    if (threadIdx.x == 0) { int s = 0; const unsigned* cnt = (const unsigned*)(a.ws + WS_CTL) + CW_CNT;
        for (int e = 0; e < NEXP; ++e) { cum[e] = s; const unsigned c = __hip_atomic_load(cnt + 64 * e, RLX_AGENT); s += (int)((c + 255u) >> 8); } cum[NEXP] = s; }
    __syncthreads();
}
__device__ __forceinline__ void phase8(const Args& a, LAS unsigned char* lds) {
    const int tid = threadIdx.x, G = gridDim.x, gtid = blockIdx.x * 512 + tid, NTH = G * 512;
    unsigned char* ws = a.ws; LAS int* cum = (LAS int*)(lds + MISC_OFF + 512);
    build_cum(a, cum);
    int* ROWMAP = (int*)(ws + WS_ROWMAP); const unsigned* cnt = (const unsigned*)(ws + WS_CTL) + CW_CNT;
    for (int i = gtid; i < NEXP * 256; i += NTH) { const int e = i >> 8, j = i & 255; const int c = (int)__hip_atomic_load(cnt + 64 * e, RLX_AGENT); const int pc = (c + 255) & ~255;
        if (c + j < pc) ROWMAP[cum[e] * 256 + c + j] = -1; }
    const i32x4* TI = (const i32x4*)(ws + WS_TI); const unsigned* BLKB = (const unsigned*)(ws + WS_BLKB);
    for (int t = gtid; t < T; t += NTH) { const i32x4 ti = TI[t]; const int blk = (t >> 5) % G;
        ROWMAP[cum[ti.x] * 256 + (int)BLKB[blk * 32 + ti.x] + ti.z] = 2 * t; ROWMAP[cum[ti.y] * 256 + (int)BLKB[blk * 32 + ti.y] + ti.w] = 2 * t + 1; }
}
__device__ __forceinline__ void phase11(const Args& a) {
    const int tid = threadIdx.x, lane = tid & 63, wave = tid >> 6, gw = blockIdx.x * 8 + wave, NGW = gridDim.x * 8;
    const bf16_t* Y2 = (const bf16_t*)(a.ws + WS_Y2); const bf16_t* X1B = (const bf16_t*)(a.ws + WS_X1B); const float* MOD = (const float*)(a.ws + WS_MOD); float* out = a.out;
    for (int t = gw; t < T; t += NGW) { const float* mod = MOD + (t >> 12) * NMODC;
        f32x4 y[8]; float s = 0.f;
#pragma unroll
        for (int j = 0; j < 8; ++j) { const int k4 = lane + 64 * j; const int p = ((const int*)((const unsigned char*)Y2 + (size_t)t * DM))[k4], q = ((const int*)((const unsigned char*)Y2 + (size_t)(T + t) * DM))[k4];
            const f32x2 p0 = __builtin_amdgcn_cvt_pk_f32_fp8(p, false), p1 = __builtin_amdgcn_cvt_pk_f32_fp8(p, true), q0 = __builtin_amdgcn_cvt_pk_f32_fp8(q, false), q1 = __builtin_amdgcn_cvt_pk_f32_fp8(q, true);
            y[j] = (f32x4){p0[0] + q0[0], p0[1] + q0[1], p1[0] + q1[0], p1[1] + q1[1]} * 0.125f; s += pg8::sq4(y[j]); }
        const float r = rsqrtf(wave_sum(s) * (1.0f / DM) + EPS);
#pragma unroll
        for (int j = 0; j < 8; ++j) { const int k4 = lane + 64 * j; const f32x4 gp = ((const f32x4*)a.in[9])[k4], g2 = ((const f32x4*)(mod + 10240))[k4];
            const u32x2 xw = ((const u32x2*)(X1B + (size_t)t * DM))[k4]; const f32x4 x1 = (f32x4){bflo(xw.x), bfhi(xw.x), bflo(xw.y), bfhi(xw.y)};
            ((f32x4*)(out + (size_t)t * DM))[k4] = x1 + g2 * (y[j] * r * gp); } }
}

__global__ void __launch_bounds__(512, 2) fwd(Args args) {
    extern __shared__ __attribute__((aligned(16))) unsigned char lds_raw[];
    LAS unsigned char* lds = (LAS unsigned char*)lds_raw;
    const int tid = threadIdx.x, G = gridDim.x;
    unsigned char* ws = args.ws;
    for (int u = opaque_tid(); u < (LDS_BYTES - MISC_OFF) / 4; u += 512) ((LAS unsigned*)(lds + MISC_OFF))[u] = 0u;
    __syncthreads();
    const int lo = args.ph_lo, hi = args.ph_hi;
    XcdBarrier bar; bar.bar = (unsigned*)(ws + WS_CTL) + CW_BAR; bar.x = 0; bar.st = nullptr;
    if (hi - lo > 1) bar = xcd_barrier_post((unsigned*)(ws + WS_CTL) + CW_BAR, (volatile LAS unsigned*)(lds + MISC_OFF));
    const int vcu = (G % 8 == 0) ? ((int)blockIdx.x % 8) * (G / 8) + (int)blockIdx.x / 8 : (int)blockIdx.x;

#define IN(k) (lo <= (k) && (k) < hi)
#define SEAM(k) do { if (IN(k) && IN((k) + 1)) xcd_barrier(bar); } while (0)
    if (IN(0)) { phase0(args, lds); } SEAM(0);
    if (IN(1)) { phase1(args, lds); } SEAM(1);
    if (IN(2)) {
        pg8::Gemm g{(const bf16_t*)(ws + WS_H), (const bf16_t*)(ws + WS_W1T), 1024, 1024, 1024, nullptr, 122}; pg8::Gemm1Order S{G, (int)blockIdx.x};
        pg8::EpiG1 E{(bf16_t*)(ws + WS_POOLIN), (bf16_t*)(ws + WS_QC), (bf16_t*)(ws + WS_KVC), (bf16_t*)(ws + WS_KR2), (bf16_t*)(ws + WS_GATES), (float*)(ws + WS_SSQQ), (float*)(ws + WS_SSQKV), (const float*)(ws + WS_CS)};
        pg8::gemm_phase<pg8::EpiG1, pg8::Gemm1Order, PG8_ALIGN, PG8_SP2, false, true>(lds, g, S, E);
        { const int nfull = 1612 % G;
          if ((int)blockIdx.x >= nfull) { __syncthreads(); late_weights(args, lds, (int)blockIdx.x - nfull, G - nfull); __syncthreads(); } }
    } SEAM(2);
    if (IN(3)) {
        { pg8::Gemm g{(const bf16_t*)(ws + WS_QC), (const bf16_t*)(ws + WS_WQT), 256, 256, 256, nullptr, 123};
          pg8::StaticOrder S; S.init(64, 12, G, (int)blockIdx.x);
          pg8::EpiQ E{(bf16_t*)(ws + WS_Q), (const float*)(ws + WS_SSQQ), (const float*)(ws + WS_CS)};
          pg8::gemm_phase<pg8::EpiQ, pg8::StaticOrder, PG8_ALIGN, PG8_SP2, false, true>(lds, g, S, E); }
        { pg8::Gemm g{(const bf16_t*)(ws + WS_KVC), (const bf16_t*)(ws + WS_WKVT), 256, 256, 256, nullptr, 123};
          pg8::StaticOrder S; S.init(68, 8, G, (int)((blockIdx.x + G - 64) % G));
          pg8::EpiK E{(unsigned char*)(ws + WS_KV), (const float*)(ws + WS_SSQKV)};
          pg8::gemm_phase<pg8::EpiK, pg8::StaticOrder, PG8_ALIGN, PG8_SP2, false, true>(lds, g, S, E); }
        {
          LAS float* rkt = (LAS float*)(lds + MISC_OFF + 4096); pg8::VtOrder S{G, (int)((blockIdx.x + 128) % G)};
          { const float* ssq = (const float*)(ws + WS_SSQKV); pg8::Unit uu;
            const int tid = opaque_tid();
            for (int i = 0; i < 8; ++i) { if (!S.next(i, uu)) break; if (tid < 256) { const f32x4 a = *(const f32x4*)(ssq + (size_t)(uu.pn * 256 + tid) * 8), b2 = *(const f32x4*)(ssq + (size_t)(uu.pn * 256 + tid) * 8 + 4);
                rkt[i * 256 + tid] = rsqrtf(((a[0] + a[1]) + (a[2] + a[3]) + (b2[0] + b2[1]) + (b2[2] + b2[3])) * (1.0f / 512.0f) + EPS); } }
            __syncthreads(); }
          pg8::Gemm g{(const bf16_t*)((const unsigned char*)(ws + WS_WKVT) + (size_t)2048 * 512), (const bf16_t*)(ws + WS_KVC), 256, 256, 256, nullptr, 127, 123};
          pg8::EpiVT E{(unsigned char*)(ws + WS_VB), rkt};
          pg8::gemm_phase<pg8::EpiVT, pg8::VtOrder, PG8_ALIGN, PG8_SP2, false, true>(lds, g, S, E); }
        { pg8::Gemm g{(const bf16_t*)(ws + WS_BPT), (const bf16_t*)(ws + WS_PW), 256, 1024, 256}; pg8::FoldOrder S{G, (int)((blockIdx.x + G - 160 % G) % G)};
          pg8::EpiPlain E{(bf16_t*)(ws + WS_WPPT), 1024};
          pg8::gemm_phase<pg8::EpiPlain, pg8::FoldOrder, PG8_ALIGN, false>(lds, g, S, E); }
        pool_diff_pass(args);
        kr_rope_pass(args);
    } SEAM(3);
    if (IN(4)) {
        for (int u = vcu; u < 1024; u += G) { const int qb = u & 15, h = (u >> 4) & 15, b = u >> 8;
            att::attn_unit((const unsigned char*)(ws + WS_Q), (const unsigned char*)(ws + WS_KV), (const unsigned char*)(ws + WS_VB), (const unsigned char*)(ws + WS_KR), (bf16_t*)(ws + WS_ATT), b, h, qb, (char*)lds_raw); }
    } SEAM(4);
    if (IN(5)) {
        if (!(blockIdx.x & 1)) { moe_cvt<0>(args, lds, (int)blockIdx.x, G); __syncthreads(); }
        { pg8::Gemm g{(const bf16_t*)(ws + WS_POOLED), (const bf16_t*)(ws + WS_WPPT), 1024, 1024, 1024}; pg8::StaticOrder S; S.init(64, 8, G, (int)blockIdx.x);
          pg8::EpiGate<false> E{(bf16_t*)(ws + WS_T1), nullptr, (const bf16_t*)(ws + WS_GATES), 0};
          pg8::gemm_phase<pg8::EpiGate<false>, pg8::StaticOrder>(lds, g, S, E); }
        if (blockIdx.x & 1) { moe_cvt<0>(args, lds, (int)blockIdx.x, G); __syncthreads(); }
        { pg8::Gemm g{(const bf16_t*)(ws + WS_ATT), (const bf16_t*)(ws + WS_WOT), 1024, 1024, 1024, nullptr, 122, 121}; pg8::StaticOrder S; S.init(64, 8, G, (int)blockIdx.x);
          pg8::EpiGate<true, true> E{(bf16_t*)(ws + WS_MERGED), (const bf16_t*)(ws + WS_T1), (const bf16_t*)(ws + WS_GATES), 2048};
          pg8::gemm_phase<pg8::EpiGate<true, true>, pg8::StaticOrder, PG8_ALIGN, PG8_SP2, false, true>(lds, g, S, E); }
    } SEAM(5);
    if (IN(6)) {
        pg8::Gemm g{(const bf16_t*)(ws + WS_MERGED), (const bf16_t*)(ws + WS_WOUTT), 1024, 1024, 1024, nullptr, 122, 123}; pg8::StaticOrder S; S.init(64, 8, G, (int)blockIdx.x);
        pg8::EpiPlain E{(bf16_t*)(ws + WS_YX), DM};
        pg8::gemm_phase<pg8::EpiPlain, pg8::StaticOrder, PG8_ALIGN, PG8_SP2, false, true>(lds, g, S, E);
    } SEAM(6);
    if (IN(7)) { phase7(args, lds); } SEAM(7);
    if (IN(9)) {
        LAS int* cum = (LAS int*)(lds + MISC_OFF + 512); build_cum(args, cum);
        LAS int* rt = (LAS int*)(lds + MISC_OFF + 4096);
        pg8::GroupedOrder S{cum, 4, G, (int)blockIdx.x};
        { const int* RM = (const int*)(ws + WS_ROWMAP2); const unsigned* cnt = (const unsigned*)(ws + WS_CTL) + CW_CNT; pg8::Unit uu;
          const int tid = opaque_tid();
          for (int i = 0; i < 8; ++i) { if (!S.next(i, uu)) break; if (tid < 256) { const int e = uu.pb >> 2, pos = (uu.pm - cum[e]) * 256 + tid;
              const int tk = pos < (int)__hip_atomic_load(cnt + 64 * e, RLX_AGENT) ? RM[e * RM_CAP + pos] : -1; rt[i * 256 + tid] = tk < 0 ? 0 : (tk >> 1); } }
          __syncthreads(); }
        pg8::Gemm g{(const bf16_t*)(ws + WS_H2), (const bf16_t*)(ws + WS_WGU), 1024, 1024, 1024, rt, 122};
        pg8::EpiGU E{(bf16_t*)(ws + WS_ACT)};
        pg8::gemm_phase<pg8::EpiGU, pg8::GroupedOrder, PG8_ALIGN, PG8_SP2, true, true>(lds, g, S, E);
        { const int tot = cum[32] * 4; int nfull = tot % G; if (G - nfull < G / 2) nfull = 0;
          if ((int)blockIdx.x >= nfull) { __syncthreads(); moe_cvt<1>(args, lds, (int)blockIdx.x - nfull, G - nfull); __syncthreads(); } }
    } SEAM(9);
    if (IN(10)) {
        LAS int* cum = (LAS int*)(lds + MISC_OFF + 512); build_cum(args, cum);
        pg8::Gemm g{(const bf16_t*)(ws + WS_ACT), (const bf16_t*)(ws + WS_WD), 256, 256, 256, nullptr, 123}; pg8::GroupedOrder S{cum, 8, G, (int)blockIdx.x};
        LAS int* tkt = (LAS int*)(lds + pg8::STAGE_BYTES); LAS float* wt = (LAS float*)(lds + pg8::STAGE_BYTES + pg8::EpiDown::DOWN_TAB * 1024);
        { const int* RM = (const int*)(ws + WS_ROWMAP2); const unsigned* cnt = (const unsigned*)(ws + WS_CTL) + CW_CNT; const float* TWf = (const float*)(ws + WS_TW); pg8::Unit uu;
          const int tid = opaque_tid();
          for (int i = 0; i < pg8::EpiDown::DOWN_TAB; ++i) { if (!S.next(i, uu)) break;
              if (tid < 256) { const int e = uu.pb >> 3, pos = (uu.pm - cum[e]) * 256 + tid;
                  const int tk = pos < (int)__hip_atomic_load(cnt + 64 * e, RLX_AGENT) ? RM[e * RM_CAP + pos] : -1; tkt[i * 256 + tid] = tk; wt[i * 256 + tid] = tk < 0 ? 0.f : TWf[tk]; } }
          __syncthreads(); }
        pg8::EpiDown E{(bf16_t*)(ws + WS_Y2), tkt, wt};
        pg8::gemm_phase<pg8::EpiDown, pg8::GroupedOrder, PG8_ALIGN, PG8_SP2, false, true>(lds, g, S, E);
    } SEAM(10);
    if (IN(11)) { phase11(args); }
#undef IN
#undef SEAM
}

extern "C" void kernel_launch(void* const* d_in, const int* in_sizes, int n_in, void* d_out, int out_size, void* d_ws, size_t ws_size, hipStream_t stream) {
    static int grid = 0;
    if (grid == 0) {
        if (n_in != 27 || in_sizes[0] != T * DM || out_size != T * DM || ws_size < WS_END) {
            fprintf(stderr, "kernel_launch: built for 27 inputs, x/out of %d floats, >= %zu bytes of workspace; got n_in %d, in0 %d, out %d, ws %zu; nothing launched\n", T * DM, (size_t)WS_END, n_in, n_in > 0 ? in_sizes[0] : -1, out_size, ws_size);
            grid = -1; return; }
        int dev = 0, cus = 0, per_cu = 0;
        if (hipGetDevice(&dev) != hipSuccess || hipDeviceGetAttribute(&cus, hipDeviceAttributeMultiprocessorCount, dev) != hipSuccess) { fprintf(stderr, "kernel_launch: device query failed\n"); grid = -1; return; }
        if (hipFuncSetAttribute((const void*)fwd, hipFuncAttributeMaxDynamicSharedMemorySize, LDS_BYTES) != hipSuccess) { fprintf(stderr, "kernel_launch: hipFuncSetAttribute failed\n"); grid = -1; return; }
        if (hipOccupancyMaxActiveBlocksPerMultiprocessor(&per_cu, (const void*)fwd, 512, LDS_BYTES) != hipSuccess || per_cu < 1)
            fprintf(stderr, "kernel_launch: note: occupancy query reports %d workgroups per CU\n", per_cu);
        (void)hipGetLastError();
        grid = cus;
    }
    if (grid < 0) return;
    if (hipMemsetAsync((char*)d_ws + WS_CTL, 0, CTL_ZERO_BYTES, stream) != hipSuccess) { fprintf(stderr, "kernel_launch: memset failed\n"); return; }
    Args a{};
    for (int i = 0; i < 27; ++i) a.in[i] = (const float*)d_in[i];
    a.out = (float*)d_out; a.ws = (unsigned char*)d_ws;
#if MK_PER_PHASE
    for (int p = 0; p < NPHASE; ++p) { a.ph_lo = p; a.ph_hi = p + 1; hipLaunchKernelGGL(fwd, dim3(grid), dim3(512), LDS_BYTES, stream, a); }
#else
    a.ph_lo = 0; a.ph_hi = NPHASE; hipLaunchKernelGGL(fwd, dim3(grid), dim3(512), LDS_BYTES, stream, a);
#endif
    const hipError_t le = hipPeekAtLastError();
    if (le != hipSuccess) fprintf(stderr, "kernel_launch: launch failed: %s\n", hipGetErrorName(le));
}
```

```cpp
#include <hip/hip_runtime.h>
#include <cstdio>
#include <cstdint>

#ifndef MK_PER_PHASE
#define MK_PER_PHASE 0
#endif

#define GAS __attribute__((address_space(1)))
#define LAS __attribute__((address_space(3)))
typedef unsigned short bf16_t;
typedef short bf16x8 __attribute__((ext_vector_type(8)));
typedef short s16x4 __attribute__((ext_vector_type(4)));
typedef float f32x2 __attribute__((ext_vector_type(2)));
typedef float f32x4 __attribute__((ext_vector_type(4)));
typedef float f32x16 __attribute__((ext_vector_type(16)));
typedef unsigned u32x2 __attribute__((ext_vector_type(2)));
typedef unsigned u32x4 __attribute__((ext_vector_type(4)));
typedef int i32x4 __attribute__((ext_vector_type(4)));
typedef int i32x8 __attribute__((ext_vector_type(8)));

constexpr int T = 16384, TC = 1024, TA = T + TC, DM = 2048, NMODC = 12288;
constexpr int N1 = 6400;
constexpr int NQ = 3072, NKV = 4096;
constexpr int NEXP = 32, DE = 512;
constexpr int HS_ROWS = 40960;
constexpr float EPS = 1e-6f;

constexpr size_t MiB = 1ull << 20, KiB = 1024;
constexpr size_t WS_CTL = 0, CTL_ZERO_BYTES = 64 * KiB;
constexpr int CW_TMO = 0, CW_BAR = 4096, CW_CNT = 8192;
constexpr size_t WS_MOD = 1 * MiB, WS_CS = 1 * MiB + 512 * KiB, WS_SSQQ = 2 * MiB, WS_SSQKV = 3 * MiB;
constexpr size_t WS_TI = 6 * MiB, WS_TW = 6 * MiB + 256 * KiB, WS_BLKB = 6 * MiB + 512 * KiB, WS_ROWMAP = 6 * MiB + 768 * KiB;
constexpr size_t WS_ROWMAP2 = 100 * MiB; constexpr int RM_CAP = 16384;
constexpr size_t WS_WRH = 7 * MiB, WS_WRL = 7 * MiB + 256 * KiB, WS_PW = 7 * MiB + 512 * KiB;
constexpr size_t WS_W1T = 8 * MiB, WS_WQT = 33 * MiB, WS_WKVT = 36 * MiB, WS_BPT = 40 * MiB, WS_WPPT = 44 * MiB, WS_WOT = 48 * MiB, WS_WOUTT = 56 * MiB;
constexpr size_t WS_H = 64 * MiB, WS_ATT = 64 * MiB, WS_H2 = 64 * MiB;
constexpr size_t WS_POOLIN = 132 * MiB, WS_QC = 164 * MiB, WS_KVC = 180 * MiB, WS_KR = 197 * MiB, WS_GATES = 200 * MiB;
constexpr size_t WS_Q = 328 * MiB, WS_KV = 424 * MiB, WS_POOLED = 560 * MiB, WS_T1 = 592 * MiB, WS_YX = 592 * MiB;
constexpr size_t WS_MERGED = 132 * MiB;
constexpr size_t WS_X1B = 132 * MiB;
constexpr size_t WS_VB = WS_KV + 34 * MiB;
constexpr size_t WS_KR2 = 656 * MiB;
constexpr size_t WS_WGU = 328 * MiB, WS_WD = 456 * MiB, WS_ACT = 520 * MiB, WS_Y2 = 560 * MiB;
constexpr size_t WS_END = 688 * MiB;

constexpr int RING_BYTES = 147456, MISC_OFF = RING_BYTES, LDS_BYTES = 163840;

#define LDS_WAIT() asm volatile("s_waitcnt lgkmcnt(0)" ::: "memory")
#define VM_WAIT() asm volatile("s_waitcnt vmcnt(0)" ::: "memory")
#define RLX_AGENT __ATOMIC_RELAXED, __HIP_MEMORY_SCOPE_AGENT
__device__ __forceinline__ unsigned f2bf(float f) { unsigned u = __builtin_bit_cast(unsigned, f); return (u + 0x7fffu + ((u >> 16) & 1u)) >> 16; }
__device__ __forceinline__ unsigned pk2(float lo, float hi) { return f2bf(lo) | (f2bf(hi) << 16); }
__device__ __forceinline__ float bflo(unsigned w) { return __uint_as_float(w << 16); }
__device__ __forceinline__ float bfhi(unsigned w) { return __uint_as_float(w & 0xffff0000u); }
typedef __bf16 bf16x2_t __attribute__((ext_vector_type(2)));
__device__ __forceinline__ unsigned cvt_pk_bf16(float lo, float hi) { const f32x2 v = {lo, hi}; return __builtin_bit_cast(unsigned, __builtin_convertvector(v, bf16x2_t)); }
__device__ __forceinline__ unsigned cvt_pk4_fp8(float a, float b, float c, float d) { int w = __builtin_amdgcn_cvt_pk_fp8_f32(a, b, 0, false); w = __builtin_amdgcn_cvt_pk_fp8_f32(c, d, w, true); return (unsigned)w; }
__device__ __forceinline__ unsigned cvt_pk4_fp8_t(float a, float b, float c, float d) { int w = __builtin_amdgcn_cvt_pk_fp8_f32(a, b, __float_as_int(a), false); w = __builtin_amdgcn_cvt_pk_fp8_f32(c, d, w, true); return (unsigned)w; }
__device__ __forceinline__ float wave_sum(float v) {
#pragma unroll
    for (int o = 1; o < 64; o <<= 1) v += __shfl_xor(v, o);
    return v;
}
__device__ __forceinline__ int opaque_tid() { int t = threadIdx.x; asm volatile("" : "+v"(t)); return t; }
__device__ __forceinline__ float sigmoidf_(float x) { return __builtin_amdgcn_rcpf(1.0f + __expf(-x)); }

#define XB_TMO      128
#define XB_XCNT(j)  (256  + 64 * (j))
#define XB_XSUB(j)  (1280 + 64 * (j))
#define XB_XGEN(j)  (2304 + 64 * (j))
#define XB_TOP      3328
#define XB_TOPGEN   3392
#define XCD_BAR_WORDS 3456
#define XB_SPIN_CAP (1u << 18)
__device__ __forceinline__ unsigned xb_ld(unsigned* p)              { return __hip_atomic_load(p, __ATOMIC_RELAXED, __HIP_MEMORY_SCOPE_AGENT); }
__device__ __forceinline__ unsigned xb_add(unsigned* p, unsigned v) { return __hip_atomic_fetch_add(p, v, __ATOMIC_RELAXED, __HIP_MEMORY_SCOPE_AGENT); }
__device__ __forceinline__ unsigned xb_xcc_id() { return (unsigned)__builtin_amdgcn_s_getreg((3 << 11) | 20) & 0xFu; }
#define XB_SPIN(cond, bar) do { unsigned _sp = 0; while (cond) { __builtin_amdgcn_s_sleep(1); \
    if ((++_sp & 255u) == 0u) { if (xb_ld(&(bar)[XB_TMO])) break; if (_sp > XB_SPIN_CAP) { atomicAdd(&(bar)[XB_TMO], 1u); break; } } } } while (0)
struct XcdBarrier { unsigned* bar; unsigned x; volatile LAS unsigned* st; };
__device__ __forceinline__ XcdBarrier xcd_barrier_post(unsigned* bar, volatile LAS unsigned* st) {
    XcdBarrier b; b.bar = bar; b.x = xb_xcc_id(); b.st = st;
    if (threadIdx.x == 0) (void)xb_add(&bar[XB_XCNT(b.x)], 1u);
    return b;
}
__device__ __forceinline__ void xcd_barrier_complete(unsigned* bar, unsigned x, unsigned& nloc, unsigned& nx) {
    const unsigned G = gridDim.x * gridDim.y * gridDim.z;
    unsigned sum, cnt, mine, sp = 0u;
    for (;;) {
        sum = 0u; cnt = 0u; mine = 0u;
#pragma unroll
        for (unsigned j = 0; j < 16; ++j) { const unsigned c = xb_ld(&bar[XB_XCNT(j)]); sum += c; cnt += (c > 0u) ? 1u : 0u; mine = (j == x) ? c : mine; }
        if (sum == G) break;
        __builtin_amdgcn_s_sleep(1);
        if ((++sp & 255u) == 0u) { if (xb_ld(&bar[XB_TMO])) break; if (sp > XB_SPIN_CAP) { atomicAdd(&bar[XB_TMO], 1u); break; } }
    }
    nloc = mine > 0u ? mine : 1u; nx = cnt > 0u ? cnt : 1u;
}
__device__ __forceinline__ void xcd_barrier(const XcdBarrier& b) {
    asm volatile("s_waitcnt vmcnt(0)" ::: "memory");
    __syncthreads();
    if (threadIdx.x == 0) {
        unsigned* bar = b.bar;
        __builtin_amdgcn_s_waitcnt(0);
        unsigned nloc = b.st[0], nx = b.st[1];
        if (nloc == 0u) { xcd_barrier_complete(bar, b.x, nloc, nx); b.st[0] = nloc; b.st[1] = nx; }
        const unsigned old = xb_add(&bar[XB_XSUB(b.x)], 1u);
        const unsigned gen = old / nloc;
        if (old + 1u == (gen + 1u) * nloc) {
            __builtin_amdgcn_fence(__ATOMIC_RELEASE, "agent");
            asm volatile("s_waitcnt vmcnt(0)" ::: "memory");
            const unsigned og = xb_add(&bar[XB_TOP], 1u);
            const unsigned tg = og / nx;
            if (og + 1u == (tg + 1u) * nx) xb_add(&bar[XB_TOPGEN], 1u);
            else XB_SPIN(xb_ld(&bar[XB_TOPGEN]) == tg, bar);
            __builtin_amdgcn_fence(__ATOMIC_ACQUIRE, "agent");
            xb_add(&bar[XB_XGEN(b.x)], 1u);
            asm volatile("s_waitcnt vmcnt(0)" ::: "memory");
        } else {
            XB_SPIN(xb_ld(&bar[XB_XGEN(b.x)]) == gen, bar);
            __builtin_amdgcn_fence(__ATOMIC_ACQUIRE, "agent");
            asm volatile("s_waitcnt vmcnt(0)" ::: "memory");
        }
    }
    __syncthreads();
}

namespace pg8 {
constexpr int BM = 256, BK = 64, HALF = 128, HTB = HALF * BK * 2, STAGE_BYTES = 8 * HTB, NXCD = 8, WGM = 8;
__host__ __device__ __forceinline__ int lds_byte(int r, int c) { const int st = (r >> 4) * 2 + (c >> 5), rr = r & 15, cc = c & 31, ob = rr * 64 + cc * 2; return st * 1024 + (ob ^ (((ob >> 9) & 1) << 5)); }
__host__ __device__ __forceinline__ void stage_rc(int b, int& R, int& C) { const int st = b / 1024, sb = b % 1024, swz = sb ^ (((sb >> 9) & 1) << 5); R = (st >> 1) * 16 + swz / 64; C = (st & 1) * 32 + (swz % 64) / 2; }
__host__ __device__ __forceinline__ int perm32(int rho) { const int n = rho >> 4, i = rho & 15; return 8 * (i >> 2) + 4 * n + (i & 3); }

struct Unit { int pm, pn, pa, pb, ka, ord; };
struct Gemm { const bf16_t* A; const bf16_t* Bt; int K, lda, ldb; const LAS int* rt; int sw, sa; };

__host__ __device__ __forceinline__ void grid_unit(int L, int nM, int nN, int& pm, int& pn) {
    const int nwg = nM * nN; int wgid = L;
    { const int q = nwg / NXCD, r = nwg % NXCD, xcd = wgid % NXCD, off = wgid / NXCD; wgid = (xcd < r ? xcd * (q + 1) : r * (q + 1) + (xcd - r) * q) + off; }
    const int nig = WGM * nN, gid = wgid / nig, fm = gid * WGM, gsz = (nM - fm) < WGM ? (nM - fm) : WGM;
    pm = fm + ((wgid % nig) % gsz); pn = (wgid % nig) / gsz;
}
struct StaticOrder {
    int nM, nN, nwg, G, c;
    __device__ void init(int nM_, int nN_, int G_, int c_) { nM = nM_; nN = nN_; nwg = nM * nN; G = G_; c = c_; }
    __device__ __forceinline__ bool next(int i, Unit& u) const {
        const long L = (long)i * G + c; if (L >= nwg) return false;
        grid_unit((int)L, nM, nN, u.pm, u.pn); u.pa = u.pm; u.pb = u.pn; u.ka = 0; return true;
    }
};
struct VtOrder {
    int G, c;
    __device__ __forceinline__ bool next(int i, Unit& u) const {
        const long L = (long)i * G + c; if (L >= 8 * 68) return false;
        grid_unit((int)L, 8, 68, u.pm, u.pn); u.pa = u.pm; u.pb = u.pn; u.ka = 0; u.ord = i; return true;
    }
};
struct Gemm1Order {
    int G, c;
    __device__ __forceinline__ bool next(int i, Unit& u) const {
        const long L = (long)i * G + c; if (L >= 1612) return false;
        if (L < 1600) grid_unit((int)L, 64, 25, u.pm, u.pn);
        else { const int r = (int)L - 1600; u.pm = 64 + r / 3; const int q = r % 3; u.pn = q == 0 ? 6 : (q == 1 ? 7 : 24); }
        u.pa = u.pm; u.pb = u.pn; u.ka = 0; return true;
    }
};
struct FoldOrder {
    int G, c;
    __device__ __forceinline__ bool next(int i, Unit& u) const {
        const long L = (long)i * G + c; if (L >= 32) return false;
        const int g = (int)L >> 3; u.pm = (int)L & 7; u.pn = g; u.pa = u.pm; u.pb = g; u.ka = g * 256; return true;
    }
};
struct GroupedOrder {
    const LAS int* cum; int NC, G, c;
    __device__ __forceinline__ bool next(int i, Unit& u) const {
        const long L0 = (long)i * G + c; const long tot = (long)cum[32] * NC; if (L0 >= tot) return false;
        long L; { const int nwg = (int)tot, q = nwg / NXCD, r = nwg % NXCD, xcd = (int)(L0 % NXCD), off = (int)(L0 / NXCD); L = (xcd < r ? xcd * (q + 1) : r * (q + 1) + (xcd - r) * q) + off; }
        int e = 0;
        for (int q = 1; q < 32; ++q) if (L >= (long)cum[q] * NC) e = q;
        const int nt = cum[e + 1] - cum[e]; const int r = (int)(L - (long)cum[e] * NC);
        u.pm = u.pa = cum[e] + r % nt; u.pn = r / nt; u.pb = e * NC + u.pn; u.ka = 0; u.ord = i; return true;
    }
};

#ifndef PG8_SP2
#define PG8_SP2 true
#endif
#ifndef PG8_ALIGN
#define PG8_ALIGN true
#endif
#ifndef DMA_MMA_DEFAULT
#define DMA_MMA_DEFAULT false
#endif
template <class Epi, class Sched, bool ALIGN_EPI = PG8_ALIGN, bool SP2 = PG8_SP2, bool GATHER = false, bool FP8 = false>
__device__ __forceinline__ void gemm_phase(LAS unsigned char* lds, const Gemm g, const Sched& S, const Epi& E) {
    const int tid = opaque_tid(), wid = __builtin_amdgcn_readfirstlane(tid >> 6), lane = tid & 63, wr = wid >> 2, wc = wid & 3, fr = lane & 15, fq = lane >> 4;
    const int K = g.K, nt = K / BK;
    unsigned voffA[2], voffB[2];
#pragma unroll
    for (int i = 0; i < 2; ++i) { int R, C; stage_rc(tid * 16 + i * 8192, R, C); const int Rb = Epi::PERM ? ((R & ~31) + perm32(R & 31)) : R;
        voffA[i] = (unsigned)(R * g.lda + C) * 2u; voffB[i] = (unsigned)(Rb * g.ldb + C) * 2u; }
    const size_t kstep = (size_t)(BK * 2);
    const size_t hstepA = GATHER ? (size_t)0 : (size_t)HALF * g.lda * 2, hstepB = (size_t)HALF * g.ldb * 2;
    const size_t tstepA = GATHER ? (size_t)0 : (size_t)BM * g.lda * 2, tstepB = 2 * hstepB;
    int gR[2]; unsigned gC[2]; unsigned oA0[2] = {0u, 0u}, oA1[2] = {0u, 0u}, oN0[2] = {0u, 0u}, oN1[2] = {0u, 0u};
    if constexpr (GATHER) {
#pragma unroll
        for (int i = 0; i < 2; ++i) { int R, C; stage_rc(tid * 16 + i * 8192, R, C); gR[i] = R; gC[i] = (unsigned)C * 2u; }
    }
#define PG8_GOFF(o0, o1, u_) do { _Pragma("unroll") for (int _i = 0; _i < 2; ++_i) { \
        o0[_i] = (unsigned)g.rt[(u_) * 256 + gR[_i]] * (unsigned)(g.lda * 2) + gC[_i]; o1[_i] = (unsigned)g.rt[(u_) * 256 + 128 + gR[_i]] * (unsigned)(g.lda * 2) + gC[_i]; } } while (0)
    const unsigned ldsw = (unsigned)wid * 1024u;
    const int aoff = lds_byte(wr * 64 + fr, fq * 8), boff = lds_byte(wc * 32 + fr, fq * 8);
    const int fcol = (fq >> 1) * 32 + (fq & 1) * 16;
    const int aoffF0 = lds_byte(wr * 64 + fr, fcol), aoffF1 = lds_byte(wr * 64 + fr, fcol + 8), boffF0 = lds_byte(wc * 32 + fr, fcol), boffF1 = lds_byte(wc * 32 + fr, fcol + 8);
    const int scw = ((g.sw ? g.sw : 127) & 0xff) * 0x01010101, sc1 = ((g.sa ? g.sa : 127) & 0xff) * 0x01010101;
#define PG8_SA(b, h) (((b) * 2 + (h)) * HTB)
#define PG8_SB(b, h) ((4 + (b) * 2 + (h)) * HTB)
#define PG8_STAGE(bufoff, gbase, voff) do { _Pragma("unroll") for (int _i = 0; _i < 2; ++_i) \
        __builtin_amdgcn_global_load_lds((const unsigned*)((const char*)(gbase) + (voff)[_i]), (LAS unsigned*)(lds + (bufoff) + ldsw + _i * 8192), 16, 0, 0); } while (0)
#define PG8_LD8(off0, off1) __builtin_shufflevector(*(const LAS i32x4*)(lds + (off0)), *(const LAS i32x4*)(lds + (off1)), 0, 1, 2, 3, 4, 5, 6, 7)
#define PG8_LDA(dst, b, h) do { if constexpr (FP8) { _Pragma("unroll") for (int m = 0; m < 4; ++m) dst##8[m] = PG8_LD8(PG8_SA(b, h) + aoffF0 + m * 2048, PG8_SA(b, h) + aoffF1 + m * 2048); } \
        else { _Pragma("unroll") for (int m = 0; m < 4; ++m) _Pragma("unroll") for (int k = 0; k < 2; ++k) dst[m][k] = *(const LAS bf16x8*)(lds + PG8_SA(b, h) + aoff + m * 2048 + k * 1024); } } while (0)
#define PG8_LDB(dst, b, h) do { if constexpr (FP8) { _Pragma("unroll") for (int n = 0; n < 2; ++n) dst##8[n] = PG8_LD8(PG8_SB(b, h) + boffF0 + n * 2048, PG8_SB(b, h) + boffF1 + n * 2048); } \
        else { _Pragma("unroll") for (int n = 0; n < 2; ++n) _Pragma("unroll") for (int k = 0; k < 2; ++k) dst[n][k] = *(const LAS bf16x8*)(lds + PG8_SB(b, h) + boff + n * 2048 + k * 1024); } } while (0)
#define PG8_MMA(ai, bj, At, Bt) do { __builtin_amdgcn_s_setprio(1); if constexpr (FP8) { _Pragma("unroll") for (int m = 0; m < 4; ++m) _Pragma("unroll") for (int n = 0; n < 2; ++n) \
        asm volatile("v_mfma_scale_f32_16x16x128_f8f6f4 %0, %1, %2, %0, %3, %4 op_sel_hi:[0,0,0]" : "+v"(acc[ai][bj][m][n]) : "v"(Bt##8[n]), "v"(At##8[m]), "v"(scw), "v"(sc1)); } \
        else { _Pragma("unroll") for (int m = 0; m < 4; ++m) _Pragma("unroll") for (int n = 0; n < 2; ++n) _Pragma("unroll") for (int k = 0; k < 2; ++k) \
        acc[ai][bj][m][n] = __builtin_amdgcn_mfma_f32_16x16x32_bf16(Bt[n][k], At[m][k], acc[ai][bj][m][n], 0, 0, 0); } __builtin_amdgcn_s_setprio(0); } while (0)
#define PG8_MMA_H(ai, bj, At, Bt, m0_) do { if constexpr (FP8) { _Pragma("unroll") for (int m = (m0_); m < (m0_) + 2; ++m) _Pragma("unroll") for (int n = 0; n < 2; ++n) \
        asm volatile("v_mfma_scale_f32_16x16x128_f8f6f4 %0, %1, %2, %0, %3, %4 op_sel_hi:[0,0,0]" : "+v"(acc[ai][bj][m][n]) : "v"(Bt##8[n]), "v"(At##8[m]), "v"(scw), "v"(sc1)); } \
        else { _Pragma("unroll") for (int m = (m0_); m < (m0_) + 2; ++m) _Pragma("unroll") for (int n = 0; n < 2; ++n) _Pragma("unroll") for (int k = 0; k < 2; ++k) \
        acc[ai][bj][m][n] = __builtin_amdgcn_mfma_f32_16x16x32_bf16(Bt[n][k], At[m][k], acc[ai][bj][m][n], 0, 0, 0); } } while (0)
#define PG8_MMA2(ai, At, P1, P2, P3) do { __builtin_amdgcn_s_setprio(1); PG8_MMA_H(ai, 0, At, B0, 0); PG8_SCHED; P1; PG8_SCHED; PG8_MMA_H(ai, 0, At, B0, 2); PG8_SCHED; P2; PG8_SCHED; \
        PG8_MMA_H(ai, 1, At, B1, 0); PG8_SCHED; P3; PG8_SCHED; PG8_MMA_H(ai, 1, At, B1, 2); __builtin_amdgcn_s_setprio(0); } while (0)
#define PG8_WAIT_V(n) asm volatile("s_waitcnt vmcnt(" #n ")" ::: "memory")
#define PG8_WAIT_L(n) asm volatile("s_waitcnt lgkmcnt(" #n ")" ::: "memory")
#define PG8_BAR __builtin_amdgcn_s_barrier()
#define PG8_SCHED __builtin_amdgcn_sched_barrier(0)
    Unit cur, nxt; int ui = 0;
    if (!S.next(0, cur)) return;
    f32x4 acc[2][2][4][2];
#pragma unroll
    for (int a = 0; a < 2; ++a)
#pragma unroll
        for (int b = 0; b < 2; ++b)
#pragma unroll
            for (int m = 0; m < 4; ++m)
#pragma unroll
                for (int n = 0; n < 2; ++n) acc[a][b][m][n] = (f32x4){0.f, 0.f, 0.f, 0.f};
    bf16x8 At[4][2], B0[2][2], B1[2][2]; i32x8 At8[4], B08[2], B18[2];
    const char* cA = (const char*)g.A + (size_t)cur.pa * tstepA + (size_t)cur.ka * 2; const char* cB = (const char*)g.Bt + (size_t)cur.pb * tstepB;
    if constexpr (GATHER) PG8_GOFF(oA0, oA1, 0);
    const unsigned* vAc0 = GATHER ? oA0 : voffA; const unsigned* vAc1 = GATHER ? oA1 : voffA;
    if constexpr (SP2) {
        PG8_STAGE(PG8_SB(0, 0), cB, voffB); PG8_STAGE(PG8_SB(0, 1), cB + hstepB, voffB); PG8_STAGE(PG8_SA(0, 0), cA, vAc0); PG8_STAGE(PG8_SA(0, 1), cA + hstepA, vAc1);
        if (wr == 1) PG8_BAR;
        PG8_WAIT_V(2); PG8_BAR;
        PG8_STAGE(PG8_SB(1, 0), cB + kstep, voffB); PG8_STAGE(PG8_SA(1, 0), cA + kstep, vAc0); PG8_STAGE(PG8_SB(1, 1), cB + hstepB + kstep, voffB);
        PG8_WAIT_V(6); PG8_BAR;
    } else {
        PG8_STAGE(PG8_SB(0, 0), cB, voffB); PG8_STAGE(PG8_SA(0, 0), cA, vAc0); PG8_STAGE(PG8_SB(0, 1), cB + hstepB, voffB); PG8_STAGE(PG8_SA(0, 1), cA + hstepA, vAc1);
        if (wr == 1) PG8_BAR;
        PG8_WAIT_V(4); PG8_BAR;
        PG8_STAGE(PG8_SB(1, 0), cB + kstep, voffB); PG8_STAGE(PG8_SA(1, 0), cA + kstep, vAc0); PG8_STAGE(PG8_SB(1, 1), cB + hstepB + kstep, voffB);
        PG8_WAIT_V(6); PG8_BAR;
    }
    for (;;) {
        const bool has_next = S.next(ui + 1, nxt);
        const char* nA = has_next ? (const char*)g.A + (size_t)nxt.pa * tstepA + (size_t)nxt.ka * 2 : cA; const char* nB = has_next ? (const char*)g.Bt + (size_t)nxt.pb * tstepB : cB;
        if constexpr (GATHER) { if (has_next) PG8_GOFF(oN0, oN1, ui + 1); else {
#pragma unroll
            for (int _i = 0; _i < 2; ++_i) { oN0[_i] = oA0[_i]; oN1[_i] = oA1[_i]; } } }
        for (int t = 0; t < nt; t += 2) {
            const bool last = (t == nt - 2);
            const char* a1 = cA + (size_t)(t + 1) * kstep;
            const char* a2 = last ? nA : cA + (size_t)(t + 2) * kstep; const char* b2 = last ? nB : cB + (size_t)(t + 2) * kstep;
            const char* a3 = a2 + kstep; const char* b3 = b2 + kstep;
            unsigned sT0[2], sT1[2];
#pragma unroll
            for (int _i = 0; _i < 2; ++_i) { sT0[_i] = GATHER ? (last ? oN0[_i] : oA0[_i]) : voffA[_i]; sT1[_i] = GATHER ? (last ? oN1[_i] : oA1[_i]) : voffA[_i]; }
            if constexpr (SP2) {
            if constexpr (Epi::DMA_MMA && FP8) {
            PG8_LDB(B0, 0, 0); PG8_LDB(B1, 0, 1); PG8_SCHED; PG8_LDA(At, 0, 0);
            PG8_WAIT_V(6); PG8_WAIT_L(0); PG8_BAR; PG8_MMA2(0, At, , PG8_STAGE(PG8_SA(1, 1), a1 + hstepA, vAc1), ); PG8_BAR; PG8_SCHED;
            PG8_LDA(At, 0, 1);
            PG8_WAIT_V(2); PG8_WAIT_L(0); PG8_BAR; PG8_MMA2(1, At, PG8_STAGE(PG8_SB(0, 0), b2, voffB), PG8_STAGE(PG8_SB(0, 1), b2 + hstepB, voffB), PG8_STAGE(PG8_SA(0, 0), a2, sT0)); PG8_BAR; PG8_SCHED;
            PG8_LDB(B0, 1, 0); PG8_LDB(B1, 1, 1); PG8_SCHED; PG8_LDA(At, 1, 0);
            PG8_WAIT_V(6); PG8_WAIT_L(0); PG8_BAR; PG8_MMA2(0, At, , PG8_STAGE(PG8_SA(0, 1), a2 + hstepA, sT1), ); PG8_BAR; PG8_SCHED;
            PG8_LDA(At, 1, 1);
            PG8_WAIT_V(2); PG8_WAIT_L(0); PG8_BAR; PG8_MMA2(1, At, PG8_STAGE(PG8_SB(1, 0), b3, voffB), PG8_STAGE(PG8_SB(1, 1), b3 + hstepB, voffB), PG8_STAGE(PG8_SA(1, 0), a3, sT0)); PG8_BAR; PG8_SCHED;
            } else {
            PG8_LDB(B0, 0, 0); PG8_LDB(B1, 0, 1); PG8_SCHED; PG8_LDA(At, 0, 0); PG8_STAGE(PG8_SA(1, 1), a1 + hstepA, vAc1);
            PG8_WAIT_V(8); PG8_WAIT_L(0); PG8_BAR; PG8_MMA(0, 0, At, B0); PG8_MMA(0, 1, At, B1); PG8_BAR; PG8_SCHED;
            PG8_LDA(At, 0, 1); PG8_STAGE(PG8_SB(0, 0), b2, voffB); PG8_STAGE(PG8_SB(0, 1), b2 + hstepB, voffB); PG8_STAGE(PG8_SA(0, 0), a2, sT0);
            PG8_WAIT_V(8); PG8_WAIT_L(0); PG8_BAR; PG8_MMA(1, 0, At, B0); PG8_MMA(1, 1, At, B1); PG8_BAR; PG8_SCHED;
            PG8_LDB(B0, 1, 0); PG8_LDB(B1, 1, 1); PG8_SCHED; PG8_LDA(At, 1, 0); PG8_STAGE(PG8_SA(0, 1), a2 + hstepA, sT1);
            PG8_WAIT_V(8); PG8_WAIT_L(0); PG8_BAR; PG8_MMA(0, 0, At, B0); PG8_MMA(0, 1, At, B1); PG8_BAR; PG8_SCHED;
            PG8_LDA(At, 1, 1); PG8_STAGE(PG8_SB(1, 0), b3, voffB); PG8_STAGE(PG8_SB(1, 1), b3 + hstepB, voffB); PG8_STAGE(PG8_SA(1, 0), a3, sT0);
            PG8_WAIT_V(8); PG8_WAIT_L(0); PG8_BAR; PG8_MMA(1, 0, At, B0); PG8_MMA(1, 1, At, B1); PG8_BAR; PG8_SCHED;
            }
            } else {
            PG8_LDB(B0, 0, 0); PG8_SCHED; PG8_LDA(At, 0, 0); PG8_STAGE(PG8_SA(1, 1), a1 + hstepA, vAc1);
            PG8_WAIT_L(8); PG8_BAR; PG8_WAIT_L(0); PG8_MMA(0, 0, At, B0); PG8_BAR; PG8_SCHED;
            PG8_LDB(B1, 0, 1); PG8_STAGE(PG8_SB(0, 0), b2, voffB);
            PG8_BAR; PG8_WAIT_L(0); PG8_MMA(0, 1, At, B1); PG8_BAR;
            PG8_LDA(At, 0, 1); PG8_STAGE(PG8_SA(0, 0), a2, sT0);
            PG8_BAR; PG8_WAIT_L(0); PG8_MMA(1, 0, At, B0); PG8_BAR; PG8_SCHED;
            PG8_STAGE(PG8_SB(0, 1), b2 + hstepB, voffB);
            PG8_WAIT_V(6); PG8_BAR; PG8_MMA(1, 1, At, B1); PG8_BAR;
            PG8_LDB(B0, 1, 0); PG8_SCHED; PG8_LDA(At, 1, 0); PG8_STAGE(PG8_SA(0, 1), a2 + hstepA, sT1);
            PG8_WAIT_L(8); PG8_BAR; PG8_WAIT_L(0); PG8_MMA(0, 0, At, B0); PG8_BAR; PG8_SCHED;
            PG8_LDB(B1, 1, 1); PG8_STAGE(PG8_SB(1, 0), b3, voffB);
            PG8_BAR; PG8_WAIT_L(0); PG8_MMA(0, 1, At, B1); PG8_BAR;
            PG8_LDA(At, 1, 1); PG8_STAGE(PG8_SA(1, 0), a3, sT0);
            PG8_BAR; PG8_WAIT_L(0); PG8_MMA(1, 0, At, B0); PG8_BAR; PG8_SCHED;
            PG8_STAGE(PG8_SB(1, 1), b3 + hstepB, voffB);
            PG8_WAIT_V(6); PG8_BAR; PG8_MMA(1, 1, At, B1); PG8_BAR;
                    }
        }
        if constexpr (FP8) asm volatile("s_nop 15\n\ts_nop 15\n\ts_nop 15\n\ts_nop 15" ::: "memory");
        if constexpr (ALIGN_EPI) { if (wr == 0) PG8_BAR; }
        { const int te = opaque_tid(), we = __builtin_amdgcn_readfirstlane(te >> 6);
          E(acc, cur, we >> 2, we & 3, te & 15, (te & 63) >> 4); }
        if (!has_next) break;
#pragma unroll
        for (int a = 0; a < 2; ++a)
#pragma unroll
            for (int b = 0; b < 2; ++b)
#pragma unroll
                for (int m = 0; m < 4; ++m)
#pragma unroll
                    for (int n = 0; n < 2; ++n) acc[a][b][m][n] = (f32x4){0.f, 0.f, 0.f, 0.f};
        cur = nxt; cA = nA; cB = nB; ++ui;
        if constexpr (GATHER) {
#pragma unroll
            for (int _i = 0; _i < 2; ++_i) { oA0[_i] = oN0[_i]; oA1[_i] = oN1[_i]; } }
        if constexpr (ALIGN_EPI) { if (wr == 1) PG8_BAR; }
    }
    PG8_WAIT_V(0);
    if constexpr (!ALIGN_EPI) { if (wr == 0) PG8_BAR; }
    PG8_BAR;
#undef PG8_GOFF
#undef PG8_LD8
#undef PG8_SA
#undef PG8_SB
#undef PG8_STAGE
#undef PG8_LDA
#undef PG8_LDB
#undef PG8_MMA
#undef PG8_MMA_H
#undef PG8_MMA2
#undef PG8_WAIT_V
#undef PG8_WAIT_L
#undef PG8_BAR
#undef PG8_SCHED
}

__device__ __forceinline__ u32x4 pack8(const f32x4 v0, const f32x4 v1) { u32x4 w; w.x = cvt_pk_bf16(v0[0], v0[1]); w.y = cvt_pk_bf16(v0[2], v0[3]); w.z = cvt_pk_bf16(v1[0], v1[1]); w.w = cvt_pk_bf16(v1[2], v1[3]); return w; }
__device__ __forceinline__ float fq_sum(float s) {
    { auto r = __builtin_amdgcn_permlane16_swap(__float_as_uint(s), __float_as_uint(s), false, false); s = __uint_as_float(r[0]) + __uint_as_float(r[1]); }
    { auto r = __builtin_amdgcn_permlane32_swap(__float_as_uint(s), __float_as_uint(s), false, false); s = __uint_as_float(r[0]) + __uint_as_float(r[1]); }
    return s;
}
__device__ __forceinline__ float sq4(const f32x4 v) { return (v[0] * v[0] + v[1] * v[1]) + (v[2] * v[2] + v[3] * v[3]); }
__device__ __forceinline__ void rope8(f32x4& v0, f32x4& v1, const float* cs  ) {
    const f32x4 a = *(const f32x4*)cs, b = *(const f32x4*)(cs + 4);
    f32x4 o0, o1;
    o0[0] = v0[0] * a[0] - v0[1] * a[1]; o0[1] = v0[1] * a[0] + v0[0] * a[1];
    o0[2] = v0[2] * a[2] - v0[3] * a[3]; o0[3] = v0[3] * a[2] + v0[2] * a[3];
    o1[0] = v1[0] * b[0] - v1[1] * b[1]; o1[1] = v1[1] * b[0] + v1[0] * b[1];
    o1[2] = v1[2] * b[2] - v1[3] * b[3]; o1[3] = v1[3] * b[2] + v1[2] * b[3];
    v0 = o0; v1 = o1;
}

__device__ __forceinline__ void rope8v(f32x4& v0, f32x4& v1, const f32x4 a, const f32x4 b) {
    f32x4 o0, o1;
    o0[0] = v0[0] * a[0] - v0[1] * a[1]; o0[1] = v0[1] * a[0] + v0[0] * a[1];
    o0[2] = v0[2] * a[2] - v0[3] * a[3]; o0[3] = v0[3] * a[2] + v0[2] * a[3];
    o1[0] = v1[0] * b[0] - v1[1] * b[1]; o1[1] = v1[1] * b[0] + v1[0] * b[1];
    o1[2] = v1[2] * b[2] - v1[3] * b[3]; o1[3] = v1[3] * b[2] + v1[2] * b[3];
    v0 = o0; v1 = o1;
}
typedef const f32x4 (&AccRef)[2][2][4][2];

struct EpiG1 {
    static constexpr bool PERM = true; static constexpr bool DMA_MMA = true;
    bf16_t *pool_in, *qc, *kvc, *kr, *gates; float *ssq_q, *ssq_kv; const float* cs;
    template <int MODE  >
    __device__ __forceinline__ void tile(AccRef acc, bf16_t* base, int ld, int col0, float* ssq, int slot, int row0, int fq) const {
#pragma unroll
        for (int ai = 0; ai < 2; ++ai)
#pragma unroll
            for (int m = 0; m < 4; ++m) { const int row = row0 + ai * HALF + m * 16; bf16_t* rowp = base + (size_t)row * ld + col0; float s = 0.f;
#pragma unroll
                for (int bj = 0; bj < 2; ++bj) { f32x4 v0 = acc[ai][bj][m][0], v1 = acc[ai][bj][m][1];
                    if (MODE == 2) s += sq4(v0) + sq4(v1);
                    if (MODE == 1) {
#pragma unroll
                        for (int j = 0; j < 4; ++j) { v0[j] = sigmoidf_(v0[j]); v1[j] = sigmoidf_(v1[j]); } }
                    if (MODE == 2) { u32x2 w8; w8.x = cvt_pk4_fp8(v0[0], v0[1], v0[2], v0[3]); w8.y = cvt_pk4_fp8(v1[0], v1[1], v1[2], v1[3]); *(u32x2*)((unsigned char*)base + (size_t)row * ld + col0 + bj * HALF) = w8; }
                    else *(u32x4*)(rowp + bj * HALF) = pack8(v0, v1); }
                if (MODE == 2) { s = fq_sum(s); if (fq == 0) ssq[(size_t)row * 8 + slot] = s; } }
    }
    __device__ __forceinline__ void operator()(AccRef acc, const Unit& u, int wr, int wc, int fr, int fq) const {
        const int row0 = u.pm * BM + wr * 64 + fr, cl = wc * 32 + 8 * fq, pn = u.pn;
        if (pn < 4) tile<0>(acc, pool_in, 1024, pn * 256 + cl, nullptr, 0, row0, fq);
        else if (pn < 6) tile<2>(acc, qc, 512, (pn - 4) * 256 + cl, ssq_q, (pn - 4) * 4 + wc, row0, fq);
        else if (pn < 8) tile<2>(acc, kvc, 512, (pn - 6) * 256 + cl, ssq_kv, (pn - 6) * 4 + wc, row0, fq);
        else if (pn < 24) tile<1>(acc, gates, 4096, (pn - 8) * 256 + cl, nullptr, 0, row0, fq);
        else tile<0>(acc, kr, 256, cl, nullptr, 0, row0, fq);
    }
};
struct EpiQ {
    static constexpr bool PERM = true; static constexpr bool DMA_MMA = DMA_MMA_DEFAULT;
    bf16_t* q; const float* ssq; const float* cs;
    __device__ __forceinline__ void operator()(AccRef acc, const Unit& u, int wr, int wc, int fr, int fq) const {
        const int row0 = u.pm * BM + wr * 64 + fr, col0 = u.pn * BM + wc * 32 + 8 * fq; const bool rope = u.pn >= 8;
        f32x2 part[2][4];
#pragma unroll
        for (int ai = 0; ai < 2; ++ai)
#pragma unroll
            for (int m = 0; m < 4; ++m) part[ai][m] = *(const f32x2*)(ssq + (size_t)(row0 + ai * HALF + m * 16) * 8 + 2 * fq);
        f32x4 csv[4][2];
        if (rope) {
            if (wc & 1) {
#pragma unroll
                for (int m = 0; m < 4; ++m) { const float* p = cs + ((m * 16 + fr) * 16 + 4 * fq) * 2; csv[m][0] = *(const f32x4*)p; csv[m][1] = *(const f32x4*)(p + 4); }
            } else {
#pragma unroll
                for (int ai = 0; ai < 2; ++ai) { const float* p = cs + ((((u.pm * 4 + wr + ai * 2) & 63)) * 16 + 4 * fq) * 2; csv[ai][0] = *(const f32x4*)p; csv[ai][1] = *(const f32x4*)(p + 4); csv[2 + ai][0] = csv[ai][0]; csv[2 + ai][1] = csv[ai][1]; }
            }
        }
        float rq[2][4];
#pragma unroll
        for (int ai = 0; ai < 2; ++ai)
#pragma unroll
            for (int m = 0; m < 4; ++m) rq[ai][m] = rsqrtf(fq_sum(part[ai][m][0] + part[ai][m][1]) * (1.0f / 512.0f) + EPS);
#pragma unroll
        for (int ai = 0; ai < 2; ++ai)
#pragma unroll
            for (int m = 0; m < 4; ++m) { const int row = row0 + ai * HALF + m * 16;
#pragma unroll
                for (int bj = 0; bj < 2; ++bj) { f32x4 v0 = acc[ai][bj][m][0] * rq[ai][m], v1 = acc[ai][bj][m][1] * rq[ai][m];
                    if (rope) { if (wc & 1) rope8v(v0, v1, csv[m][0], csv[m][1]); else rope8v(v0, v1, csv[ai][0], csv[ai][1]); }
                    u32x2 w8; w8.x = cvt_pk4_fp8(v0[0], v0[1], v0[2], v0[3]); w8.y = cvt_pk4_fp8(v1[0], v1[1], v1[2], v1[3]);
                    *(u32x2*)((unsigned char*)q + (size_t)row * NQ + col0 + bj * HALF) = w8; } }
    }
};
struct EpiK {
    static constexpr bool PERM = true; static constexpr bool DMA_MMA = DMA_MMA_DEFAULT;
    unsigned char* kn; const float* ssq;
    __device__ __forceinline__ void operator()(AccRef acc, const Unit& u, int wr, int wc, int fr, int fq) const {
        const int row0 = u.pm * BM + wr * 64 + fr, col0 = u.pn * BM + wc * 32 + 8 * fq;
        f32x2 part[2][4];
#pragma unroll
        for (int ai = 0; ai < 2; ++ai)
#pragma unroll
            for (int m = 0; m < 4; ++m) part[ai][m] = *(const f32x2*)(ssq + (size_t)(row0 + ai * HALF + m * 16) * 8 + 2 * fq);
        float rk[2][4];
#pragma unroll
        for (int ai = 0; ai < 2; ++ai)
#pragma unroll
            for (int m = 0; m < 4; ++m) rk[ai][m] = rsqrtf(fq_sum(part[ai][m][0] + part[ai][m][1]) * (1.0f / 512.0f) + EPS);
#pragma unroll
        for (int ai = 0; ai < 2; ++ai)
#pragma unroll
            for (int m = 0; m < 4; ++m) { const int row = row0 + ai * HALF + m * 16;
#pragma unroll
                for (int bj = 0; bj < 2; ++bj) { const f32x4 k0 = acc[ai][bj][m][0] * rk[ai][m], k1 = acc[ai][bj][m][1] * rk[ai][m];
                    u32x2 w8; w8.x = cvt_pk4_fp8(k0[0], k0[1], k0[2], k0[3]); w8.y = cvt_pk4_fp8(k1[0], k1[1], k1[2], k1[3]);
                    *(u32x2*)(kn + (size_t)row * 2048 + col0 + bj * HALF) = w8; } }
    }
};
struct EpiVT {
    static constexpr bool PERM = true; static constexpr bool DMA_MMA = DMA_MMA_DEFAULT;
    unsigned char* vt; const LAS float* rkt;
    __device__ __forceinline__ void operator()(AccRef acc, const Unit& u, int wr, int wc, int fr, int fq) const {
        const int row0 = u.pm * BM + wr * 64 + fr, cl = wc * 32 + 8 * fq;
        f32x4 s0[2], s1[2];
#pragma unroll
        for (int bj = 0; bj < 2; ++bj) { s0[bj] = *(const LAS f32x4*)(rkt + u.ord * 256 + bj * HALF + cl); s1[bj] = *(const LAS f32x4*)(rkt + u.ord * 256 + bj * HALF + cl + 4); }
#pragma unroll
        for (int ai = 0; ai < 2; ++ai)
#pragma unroll
            for (int m = 0; m < 4; ++m) { const int row = row0 + ai * HALF + m * 16;
#pragma unroll
                for (int bj = 0; bj < 2; ++bj) { const f32x4 v0 = acc[ai][bj][m][0] * s0[bj], v1 = acc[ai][bj][m][1] * s1[bj];
                    u32x2 w8; w8.x = cvt_pk4_fp8(v0[0], v0[1], v0[2], v0[3]); w8.y = cvt_pk4_fp8(v1[0], v1[1], v1[2], v1[3]);
                    *(u32x2*)(vt + (size_t)row * TA + u.pn * BM + bj * HALF + cl) = w8; } }
    }
};
struct EpiPlain {
    static constexpr bool PERM = true; static constexpr bool DMA_MMA = true;
    bf16_t* o; int ldc;
    __device__ __forceinline__ void operator()(AccRef acc, const Unit& u, int wr, int wc, int fr, int fq) const {
        const int row0 = u.pm * BM + wr * 64 + fr, col0 = u.pn * BM + wc * 32 + 8 * fq;
#pragma unroll
        for (int ai = 0; ai < 2; ++ai)
#pragma unroll
            for (int m = 0; m < 4; ++m) { const int row = row0 + ai * HALF + m * 16;
#pragma unroll
                for (int bj = 0; bj < 2; ++bj) *(u32x4*)(o + (size_t)row * ldc + col0 + bj * HALF) = pack8(acc[ai][bj][m][0], acc[ai][bj][m][1]); }
    }
};
__device__ __forceinline__ void unpack8(const u32x4 w, f32x4& a, f32x4& b) { a[0] = bflo(w.x); a[1] = bfhi(w.x); a[2] = bflo(w.y); a[3] = bfhi(w.y); b[0] = bflo(w.z); b[1] = bfhi(w.z); b[2] = bflo(w.w); b[3] = bfhi(w.w); }
struct EpiPlain8 {
    static constexpr bool PERM = true; static constexpr bool DMA_MMA = false;
    unsigned char* o; int ldc; float sc;
    __device__ __forceinline__ void operator()(AccRef acc, const Unit& u, int wr, int wc, int fr, int fq) const {
        const int row0 = u.pm * BM + wr * 64 + fr, col0 = u.pn * BM + wc * 32 + 8 * fq;
#pragma unroll
        for (int ai = 0; ai < 2; ++ai)
#pragma unroll
            for (int m = 0; m < 4; ++m) { const int row = row0 + ai * HALF + m * 16;
#pragma unroll
                for (int bj = 0; bj < 2; ++bj) { const f32x4 v0 = acc[ai][bj][m][0] * sc, v1 = acc[ai][bj][m][1] * sc; u32x2 w8; w8.x = cvt_pk4_fp8(v0[0], v0[1], v0[2], v0[3]); w8.y = cvt_pk4_fp8(v1[0], v1[1], v1[2], v1[3]);
                    *(u32x2*)(o + (size_t)row * ldc + col0 + bj * HALF) = w8; } }
    }
};
template <bool ADD, bool O8 = false> struct EpiGate {
    static constexpr bool PERM = true; static constexpr bool DMA_MMA = ADD;
    bf16_t* o; const bf16_t* prev; const bf16_t* gates; int gcol0;
    __device__ __forceinline__ void operator()(AccRef acc, const Unit& u, int wr, int wc, int fr, int fq) const {
        const int row0 = u.pm * BM + wr * 64 + fr, col0 = u.pn * BM + wc * 32 + 8 * fq;
#pragma unroll
        for (int ai = 0; ai < 2; ++ai) {
            u32x4 gw[4][2], pw[4][2];
#pragma unroll
            for (int m = 0; m < 4; ++m)
#pragma unroll
                for (int bj = 0; bj < 2; ++bj) { const int row = row0 + ai * HALF + m * 16, col = col0 + bj * HALF;
                    gw[m][bj] = *(const u32x4*)(gates + (size_t)row * 4096 + gcol0 + col);
                    if (ADD) pw[m][bj] = *(const u32x4*)(prev + (size_t)row * DM + col); }
#pragma unroll
            for (int m = 0; m < 4; ++m)
#pragma unroll
                for (int bj = 0; bj < 2; ++bj) { const int row = row0 + ai * HALF + m * 16, col = col0 + bj * HALF;
                    f32x4 g0, g1; unpack8(gw[m][bj], g0, g1);
                    f32x4 v0 = acc[ai][bj][m][0] * g0, v1 = acc[ai][bj][m][1] * g1;
                    if (ADD) { f32x4 p0, p1; unpack8(pw[m][bj], p0, p1); v0 += p0; v1 += p1; }
                    if constexpr (O8) { v0 = v0 * 16.0f; v1 = v1 * 16.0f; u32x2 w8; w8.x = cvt_pk4_fp8(v0[0], v0[1], v0[2], v0[3]); w8.y = cvt_pk4_fp8(v1[0], v1[1], v1[2], v1[3]);
                        *(u32x2*)((unsigned char*)o + (size_t)row * DM + col) = w8; }
                    else *(u32x4*)(o + (size_t)row * DM + col) = pack8(v0, v1); }
        }
    }
};
struct EpiGU {
    static constexpr bool PERM = true; static constexpr bool DMA_MMA = DMA_MMA_DEFAULT;
    bf16_t* act;
    __device__ __forceinline__ void operator()(AccRef acc, const Unit& u, int wr, int wc, int fr, int fq) const {
        const int row0 = u.pm * BM + wr * 64 + fr, col0 = u.pn * 128 + wc * 16 + 4 * fq;
#pragma unroll
        for (int ai = 0; ai < 2; ++ai)
#pragma unroll
            for (int m = 0; m < 4; ++m) { const int row = row0 + ai * HALF + m * 16;
#pragma unroll
                for (int bj = 0; bj < 2; ++bj) { const f32x4 gt = acc[ai][bj][m][0], up = acc[ai][bj][m][1]; f32x4 v;
#pragma unroll
                    for (int j = 0; j < 4; ++j) v[j] = gt[j] * sigmoidf_(gt[j]) * up[j];
                    *(unsigned*)((unsigned char*)act + (size_t)row * DE + col0 + bj * 64) = cvt_pk4_fp8(v[0], v[1], v[2], v[3]); } }
    }
};
struct EpiDown {
    static constexpr bool PERM = true; static constexpr bool DMA_MMA = DMA_MMA_DEFAULT;
    bf16_t* y2; const LAS int* tkt; const LAS float* wt;
    static constexpr int DOWN_TAB = 8;
    __device__ __forceinline__ void operator()(AccRef acc, const Unit& u, int wr, int wc, int fr, int fq) const {
        const int col0 = u.pn * BM + wc * 32 + 8 * fq, lr = u.ord * 256 + wr * 64 + fr;
        int tk[2][4]; float w[2][4];
#pragma unroll
        for (int ai = 0; ai < 2; ++ai)
#pragma unroll
            for (int m = 0; m < 4; ++m) { tk[ai][m] = tkt[lr + ai * HALF + m * 16]; w[ai][m] = wt[lr + ai * HALF + m * 16]; }
#pragma unroll
        for (int ai = 0; ai < 2; ++ai)
#pragma unroll
            for (int m = 0; m < 4; ++m) { const int t = tk[ai][m];
                if (t >= 0) { unsigned char* dst = (unsigned char*)y2 + ((size_t)(t & 1) * T + (size_t)(t >> 1)) * DM + col0; const float w8s = w[ai][m] * 8.0f;
#pragma unroll
                    for (int bj = 0; bj < 2; ++bj) { const f32x4 v0 = acc[ai][bj][m][0] * w8s, v1 = acc[ai][bj][m][1] * w8s; u32x2 w8; w8.x = cvt_pk4_fp8(v0[0], v0[1], v0[2], v0[3]); w8.y = cvt_pk4_fp8(v1[0], v1[1], v1[2], v1[3]);
                        *(u32x2*)(dst + bj * HALF) = w8; } } }
    }
};
}

namespace att {
constexpr int NW = 8, QBLK = 32, KVBLK = 64;
constexpr float SCALE = 0.07216878364870322f;
constexpr float HEADROOM = 1.0f / 0.07216878364870322f;
constexpr float THR = 1.5f;
constexpr int LDQ = NQ, LDKN = 2048, LDVT = TA, LDKR = 64, LDO = DM;
constexpr int KP8 = 144, RP8 = 80;
constexpr int VP8 = 80;
constexpr int SHM_V = 128 * VP8, SHM_K = KVBLK * KP8, SHM_KR = KVBLK * RP8;
constexpr int NSLOT = 4;
constexpr int OFF_V = 0, OFF_K = NSLOT * SHM_V, OFF_KR = OFF_K + NSLOT * SHM_K, OFF_WS = OFF_KR + NSLOT * SHM_KR, SHM_ATTN = OFF_WS + NW * 64 * 4;
#define KSWZ(row, colB) ((row) * KP + (colB))
#define RSWZ(row, colB) ((row) * RP + (colB))
#define SBAR() __builtin_amdgcn_sched_barrier(0)
__device__ __forceinline__ int crow(int r, int hi) { return (r & 3) + 8 * (r >> 2) + 4 * hi; }
__device__ __forceinline__ void partialSM(f32x16& p0, f32x16& p1, float& m_reg, float& mn, float& alpha) {
  constexpr float C = SCALE * 1.4426950408889634f;
  float pmax = p0[0];
#pragma unroll
  for (int r = 1; r < 16; ++r) pmax = fmaxf(pmax, p0[r]);
#pragma unroll
  for (int r = 0; r < 16; ++r) pmax = fmaxf(pmax, p1[r]);
  { auto rr = __builtin_amdgcn_permlane32_swap(__float_as_uint(pmax), __float_as_uint(pmax), false, false);
    pmax = fmaxf(__uint_as_float(rr[0]), __uint_as_float(rr[1])); }
  if (__builtin_expect(__all(pmax - m_reg <= THR / SCALE), 1)) { mn = m_reg; alpha = 1.f; }
  else { mn = fmaxf(m_reg, pmax) + HEADROOM; alpha = __builtin_amdgcn_exp2f((m_reg - mn) * C); m_reg = mn; }
  float mnC = -mn * C + 6.0f;
#pragma unroll
  for (int r = 0; r < 16; ++r) p0[r] = fmaf(p0[r], C, mnC);
#pragma unroll
  for (int r = 0; r < 16; ++r) p1[r] = fmaf(p1[r], C, mnC);
#pragma unroll
  for (int r = 0; r < 16; ++r) p0[r] = __builtin_amdgcn_exp2f(p0[r]);
}
__device__ __forceinline__ void finishSM(f32x16& p0, f32x16& p1, float alpha, float& l_reg, i32x8& pa) {
#pragma unroll
  for (int r = 0; r < 16; ++r) p1[r] = __builtin_amdgcn_exp2f(p1[r]);
  float ps = 0;
#pragma unroll
  for (int r = 0; r < 16; ++r) ps += p0[r];
#pragma unroll
  for (int r = 0; r < 16; ++r) ps += p1[r];
  { auto rr = __builtin_amdgcn_permlane32_swap(__float_as_uint(ps), __float_as_uint(ps), false, false);
    ps = __uint_as_float(rr[0]) + __uint_as_float(rr[1]); }
  l_reg = l_reg * alpha + ps;
#pragma unroll
  for (int g = 0; g < 4; ++g) {
    const unsigned a = cvt_pk4_fp8(p0[4 * g], p0[4 * g + 1], p0[4 * g + 2], p0[4 * g + 3]), b = cvt_pk4_fp8(p1[4 * g], p1[4 * g + 1], p1[4 * g + 2], p1[4 * g + 3]);
    auto r = __builtin_amdgcn_permlane32_swap(a, b, false, false);
    pa[2 * g] = (int)r[0]; pa[2 * g + 1] = (int)r[1]; }
}
__device__ __forceinline__ i32x8 ld32(const char* p) { const i32x4 a = *reinterpret_cast<const i32x4*>(p), b = *reinterpret_cast<const i32x4*>(p + 16); return __builtin_shufflevector(a, b, 0, 1, 2, 3, 4, 5, 6, 7); }
#define ATT_MFMA8(P, A, B) asm volatile("v_mfma_scale_f32_32x32x64_f8f6f4 %0, %1, %2, %0, %3, %3 op_sel_hi:[0,0,0]" : "+v"(P) : "v"(A), "v"(B), "v"(one))
__device__ __forceinline__ void qkt(f32x16& p0, f32x16& p1, const char* Ks, const char* Krs, const i32x8* q8, int r32, int hi) {
  p0 = f32x16{}; p1 = f32x16{}; const int one = 0x7f7f7f7f;
  asm volatile("s_nop 1" ::: "memory");
#pragma unroll
  for (int st = 0; st < 2; ++st) {
    const i32x8 a0 = ld32(Ks + r32 * KP8 + 64 * st + 32 * hi), a1 = ld32(Ks + (32 + r32) * KP8 + 64 * st + 32 * hi);
    ATT_MFMA8(p0, a0, q8[st]); ATT_MFMA8(p1, a1, q8[st]); }
  { const i32x8 a0 = ld32(Krs + r32 * RP8 + 32 * hi), a1 = ld32(Krs + (32 + r32) * RP8 + 32 * hi);
    ATT_MFMA8(p0, a0, q8[2]); ATT_MFMA8(p1, a1, q8[2]); }
  asm volatile("s_nop 15\n\ts_nop 7" : "+v"(p0), "+v"(p1));
}
__device__ __forceinline__ void pv_d0(f32x16* o, const char* Vs, const i32x8& pa, int r32, int hi) {
  const int one = 0x7f7f7f7f;
  const i32x8 b0 = ld32(Vs + (0 * 32 + r32) * VP8 + 32 * hi), b1 = ld32(Vs + (1 * 32 + r32) * VP8 + 32 * hi), b2 = ld32(Vs + (2 * 32 + r32) * VP8 + 32 * hi), b3 = ld32(Vs + (3 * 32 + r32) * VP8 + 32 * hi);
  ATT_MFMA8(o[0], pa, b0); ATT_MFMA8(o[1], pa, b1); ATT_MFMA8(o[2], pa, b2); ATT_MFMA8(o[3], pa, b3);
}
#define ATT_MFMA8Z(P, A, B) asm volatile("v_mfma_scale_f32_32x32x64_f8f6f4 %0, %1, %2, 0, %3, %3 op_sel_hi:[0,0,0]" : "=&v"(P) : "v"(A), "v"(B), "v"(one))
template <class MID>
__device__ __forceinline__ void att_step(f32x16& y0, f32x16& y1, f32x16& z0, f32x16& z1, const i32x8& paX, i32x8& paY, float& m_reg, float& alY, float& l_reg, f32x16* o,
                                         const char* Ks, const char* Krs, const char* Vs, const i32x8* q8, int r32, int hi, int one, MID&& mid) {
  constexpr float C = SCALE * 1.4426950408889634f;
#define PIN16(v) asm volatile("" : "+v"(v))
#define CVT_G(g) do { const unsigned a_ = cvt_pk4_fp8_t(y0[4 * (g)], y0[4 * (g) + 1], y0[4 * (g) + 2], y0[4 * (g) + 3]), b_ = cvt_pk4_fp8_t(y1[4 * (g)], y1[4 * (g) + 1], y1[4 * (g) + 2], y1[4 * (g) + 3]); \
    auto r_ = __builtin_amdgcn_permlane32_swap(a_, b_, false, false); paY[2 * (g)] = (int)r_[0]; paY[2 * (g) + 1] = (int)r_[1]; } while (0)
  const i32x8 a0 = ld32(Ks + r32 * KP8 + 32 * hi), a1 = ld32(Ks + (32 + r32) * KP8 + 32 * hi);
#define MAX3(d, a, b, c) asm("v_max3_f32 %0, %1, %2, %3" : "=v"(d) : "v"(a), "v"(b), "v"(c))
  float pm0, pm1;
  MAX3(pm0, y0[0], y0[1], y0[2]); MAX3(pm1, y1[0], y1[1], y1[2]);
#pragma unroll
  for (int r = 3; r < 15; r += 2) { MAX3(pm0, pm0, y0[r], y0[r + 1]); MAX3(pm1, pm1, y1[r], y1[r + 1]); }
  MAX3(pm0, pm0, y0[15], y1[15]);
  float pmax; asm("v_max_f32 %0, %1, %2" : "=v"(pmax) : "v"(pm0), "v"(pm1));
  { auto rr = __builtin_amdgcn_permlane32_swap(__float_as_uint(pmax), __float_as_uint(pmax), false, false);
    float o0_ = __uint_as_float(rr[0]), o1_ = __uint_as_float(rr[1]); asm("v_max_f32 %0, %1, %2" : "=v"(pmax) : "v"(o0_), "v"(o1_)); }
#undef MAX3
  float mn;
  if (__builtin_expect(__all(pmax - m_reg <= THR / SCALE), 1)) { mn = m_reg; alY = 1.f; }
  else { mn = fmaxf(m_reg, pmax) + HEADROOM; alY = __builtin_amdgcn_exp2f((m_reg - mn) * C); m_reg = mn; }
  float mnC = -mn * C + 6.0f;
  asm volatile("" : "+v"(mnC), "+v"(alY), "+v"(m_reg));
  SBAR(); ATT_MFMA8Z(z0, a0, q8[0]); SBAR();
  const i32x8 c0 = ld32(Ks + r32 * KP8 + 64 + 32 * hi), c1 = ld32(Ks + (32 + r32) * KP8 + 64 + 32 * hi);
#pragma unroll
  for (int r = 0; r < 16; ++r) y0[r] = fmaf(y0[r], C, mnC);
  PIN16(y0); SBAR(); ATT_MFMA8Z(z1, a1, q8[0]); SBAR();
  mid();
#pragma unroll
  for (int r = 0; r < 16; ++r) y1[r] = fmaf(y1[r], C, mnC);
  PIN16(y1); SBAR(); ATT_MFMA8(z0, c0, q8[1]); SBAR();
  const i32x8 e0 = ld32(Krs + r32 * RP8 + 32 * hi), e1 = ld32(Krs + (32 + r32) * RP8 + 32 * hi);
#pragma unroll
  for (int r = 0; r < 8; ++r) y0[r] = __builtin_amdgcn_exp2f(y0[r]);
  PIN16(y0); SBAR(); ATT_MFMA8(z1, c1, q8[1]); SBAR();
#pragma unroll
  for (int r = 8; r < 16; ++r) y0[r] = __builtin_amdgcn_exp2f(y0[r]);
  PIN16(y0); SBAR(); ATT_MFMA8(z0, e0, q8[2]); SBAR();
  const i32x8 b0 = ld32(Vs + (0 * 32 + r32) * VP8 + 32 * hi), b1 = ld32(Vs + (1 * 32 + r32) * VP8 + 32 * hi);
#pragma unroll
  for (int r = 0; r < 8; ++r) y1[r] = __builtin_amdgcn_exp2f(y1[r]);
  PIN16(y1); SBAR(); ATT_MFMA8(z1, e1, q8[2]); SBAR();
  const i32x8 b2 = ld32(Vs + (2 * 32 + r32) * VP8 + 32 * hi), b3 = ld32(Vs + (3 * 32 + r32) * VP8 + 32 * hi);
#pragma unroll
  for (int r = 8; r < 16; ++r) y1[r] = __builtin_amdgcn_exp2f(y1[r]);
  PIN16(y1); SBAR(); ATT_MFMA8(o[0], paX, b0); SBAR();
  float ps = 0;
#pragma unroll
  for (int r = 0; r < 16; ++r) ps += y0[r];
  asm volatile("" : "+v"(ps)); SBAR(); ATT_MFMA8(o[1], paX, b1); SBAR();
#pragma unroll
  for (int r = 0; r < 16; ++r) ps += y1[r];
  { auto rr = __builtin_amdgcn_permlane32_swap(__float_as_uint(ps), __float_as_uint(ps), false, false);
    ps = __uint_as_float(rr[0]) + __uint_as_float(rr[1]); }
  l_reg = l_reg * alY + ps;
  asm volatile("" : "+v"(l_reg)); SBAR(); ATT_MFMA8(o[2], paX, b2); SBAR();
  CVT_G(0); CVT_G(1);
  asm volatile("" : "+v"(paY)); SBAR(); ATT_MFMA8(o[3], paX, b3); SBAR();
  CVT_G(2); CVT_G(3);
  asm volatile("" : "+v"(paY));
#undef PIN16
#undef CVT_G
}
__device__ __forceinline__ void attn_unit(const unsigned char* __restrict__ Q, const unsigned char* __restrict__ KN, const unsigned char* __restrict__ VT, const unsigned char* __restrict__ KR, bf16_t* __restrict__ O, int b, int h, int qb, char* lds) {
  int tid = threadIdx.x; asm volatile("" : "+v"(tid));
  const int wid = tid >> 6, lane = tid & 63, r32 = lane & 31, hi = lane >> 5;
  char* V_lds = lds + OFF_V; char* K_lds = lds + OFF_K; char* KR_lds = lds + OFF_KR;
  float* wsl = (float*)(lds + OFF_WS) + wid * 64; float* li_l = wsl; float* al_l = wsl + 32;
  float m_reg = -1e30f, l_reg = 0; f32x16 o[4] = {}; i32x8 qr[3];
  const long qrow = (long)b * 4096 + qb * 256 + wid * QBLK + r32;
  { const unsigned char* Qp = Q + qrow * LDQ;
    const i32x4 a0 = *reinterpret_cast<const i32x4*>(Qp + h * 128 + 32 * hi), a1 = *reinterpret_cast<const i32x4*>(Qp + h * 128 + 32 * hi + 16);
    const i32x4 b0 = *reinterpret_cast<const i32x4*>(Qp + h * 128 + 64 + 32 * hi), b1 = *reinterpret_cast<const i32x4*>(Qp + h * 128 + 64 + 32 * hi + 16);
    const i32x4 c0 = *reinterpret_cast<const i32x4*>(Qp + 2048 + h * 64 + 32 * hi), c1 = *reinterpret_cast<const i32x4*>(Qp + 2048 + h * 64 + 32 * hi + 16);
    qr[0] = __builtin_shufflevector(a0, a1, 0, 1, 2, 3, 4, 5, 6, 7); qr[1] = __builtin_shufflevector(b0, b1, 0, 1, 2, 3, 4, 5, 6, 7); qr[2] = __builtin_shufflevector(c0, c1, 0, 1, 2, 3, 4, 5, 6, 7); }
  const int vr_ = tid >> 2, vc_ = (tid & 3) * 16;
  const int kr_ = tid >> 3, kc_ = (tid & 7) * 16;
  const int rr_ = (tid >> 2) & 63, rc_ = (tid & 3) * 16;
  const unsigned char* Vh = VT + (size_t)(h * 128) * LDVT; const unsigned char* Kh = KN + h * 128;
  struct { i32x4 vs0, kn0, kr0; } sr_[1];
#define TROW(jt) ((long)((jt) < 64 ? b * 4096 + (jt) * 64 : T + b * 256 + ((jt) - 64) * 64))
#define SLOAD(i, jt) do { const long _r0 = TROW(jt); \
    sr_[i].vs0 = *reinterpret_cast<const i32x4*>(&Vh[(size_t)vr_ * LDVT + _r0 + vc_]); \
    sr_[i].kn0 = *reinterpret_cast<const i32x4*>(&Kh[(_r0 + kr_) * LDKN + kc_]); \
    if (wid < 4) sr_[i].kr0 = *reinterpret_cast<const i32x4*>(&KR[(_r0 + rr_) * LDKR + rc_]); } while (0)
#define SWRITE(bb, i) do { *(i32x4*)(V_lds + (bb) * SHM_V + vr_ * VP8 + vc_) = sr_[i].vs0;   \
    *(i32x4*)(K_lds + (bb) * SHM_K + kr_ * KP8 + kc_) = sr_[i].kn0;                       \
    if (wid < 4) *(i32x4*)(KR_lds + (bb) * SHM_KR + rr_ * RP8 + rc_) = sr_[i].kr0; } while (0)
#define SWAIT() asm volatile("s_waitcnt vmcnt(0)" ::: "memory")
#define RESC(a) do { if (__any((a) < 1.f)) { if (hi == 0) al_l[r32] = (a); asm volatile("s_nop 15\n\ts_nop 15\n\ts_nop 15\n\ts_nop 15\n\ts_nop 15\n\ts_nop 15\n\ts_waitcnt lgkmcnt(0)" ::: "memory"); \
    _Pragma("unroll") for (int d = 0; d < 4; ++d) _Pragma("unroll") for (int r = 0; r < 16; ++r) o[d][r] *= al_l[crow(r, hi)]; } } while (0)
  f32x16 pA0, pA1, pB0, pB1; float mnA, mnB, alA, alB; constexpr int NT = 68;
  int one = 0x7f7f7f7f; asm volatile("" : "+v"(one));
  { struct { i32x4 vs0, kn0, kr0; } pr_[3];
#pragma unroll
    for (int t = 0; t < 3; ++t) { const long _r0 = TROW(t);
      pr_[t].vs0 = *reinterpret_cast<const i32x4*>(&Vh[(size_t)vr_ * LDVT + _r0 + vc_]); pr_[t].kn0 = *reinterpret_cast<const i32x4*>(&Kh[(_r0 + kr_) * LDKN + kc_]);
      if (wid < 4) pr_[t].kr0 = *reinterpret_cast<const i32x4*>(&KR[(_r0 + rr_) * LDKR + rc_]); }
#pragma unroll
    for (int t = 0; t < 3; ++t) { *(i32x4*)(V_lds + t * SHM_V + vr_ * VP8 + vc_) = pr_[t].vs0; *(i32x4*)(K_lds + t * SHM_K + kr_ * KP8 + kc_) = pr_[t].kn0;
      if (wid < 4) *(i32x4*)(KR_lds + t * SHM_KR + rr_ * RP8 + rc_) = pr_[t].kr0; } }
  __syncthreads();
  SLOAD(0, 3);
  i32x8 pa0, pa1;
  qkt(pA0, pA1, K_lds, KR_lds, qr, r32, hi); partialSM(pA0, pA1, m_reg, mnA, alA); finishSM(pA0, pA1, alA, l_reg, pa0);
  qkt(pB0, pB1, K_lds + SHM_K, KR_lds + SHM_KR, qr, r32, hi);
#define STAGE(s_) [&]() { if ((s_) + 3 < NT) { SWAIT(); SWRITE(((s_) + 3) & 3, 0); } if ((s_) + 4 < NT) SLOAD(0, (s_) + 4); }
  for (int t = 0; t + 2 < NT; t += 2) {
    att_step(pB0, pB1, pA0, pA1, pa0, pa1, m_reg, alB, l_reg, o, K_lds + ((t + 2) & 3) * SHM_K, KR_lds + ((t + 2) & 3) * SHM_KR, V_lds + (t & 3) * SHM_V, qr, r32, hi, one, STAGE(t));
    RESC(alB); __syncthreads();
    att_step(pA0, pA1, pB0, pB1, pa1, pa0, m_reg, alA, l_reg, o, K_lds + ((t + 3) & 3) * SHM_K, KR_lds + ((t + 3) & 3) * SHM_KR, V_lds + ((t + 1) & 3) * SHM_V, qr, r32, hi, one, STAGE(t + 1));
    RESC(alA); __syncthreads();
  }
#undef STAGE
  pv_d0(o, V_lds + ((NT - 2) & 3) * SHM_V, pa0, r32, hi); SBAR();
  asm volatile("s_nop 15\n\ts_nop 7" : "+v"(pB0), "+v"(pB1));
  partialSM(pB0, pB1, m_reg, mnB, alB); finishSM(pB0, pB1, alB, l_reg, pa1); SBAR();
  RESC(alB);
  pv_d0(o, V_lds + ((NT - 1) & 3) * SHM_V, pa1, r32, hi);
  asm volatile("s_nop 15\n\ts_nop 15" ::: "memory");
  if (hi == 0) li_l[r32] = l_reg; asm volatile("s_waitcnt lgkmcnt(0)" ::: "memory");
  float rli[16];
#pragma unroll
  for (int r = 0; r < 16; ++r) rli[r] = __builtin_amdgcn_rcpf(li_l[crow(r, hi)]);
  unsigned char* Ow8 = (unsigned char*)O + ((long)b * 4096 + qb * 256 + wid * QBLK) * LDO + h * 128;
#pragma unroll
  for (int r = 0; r < 16; ++r) { int orow = crow(r, hi);
#pragma unroll
    for (int d0 = 0; d0 < 4; ++d0) { const float v = o[d0][r] * rli[r] * 64.0f; Ow8[(long)orow * LDO + d0 * 32 + r32] = (unsigned char)__builtin_amdgcn_cvt_pk_fp8_f32(v, v, 0, false); } }
  __syncthreads();
#undef TROW
#undef SLOAD
#undef SWRITE
#undef SWAIT
#undef RESC
}
}

struct Args { const float* in[27]; float* out; unsigned char* ws; int ph_lo, ph_hi; };
constexpr int NPHASE = 12;

template <class CM>
__device__ __forceinline__ void cvt_item(const CM& cm, int ldw, const float* kscale, bf16_t* WT, int ldt, LAS unsigned char* scr, int k0, int n0, int lane) {
    const int kq = lane >> 4, nq = lane & 15, kb = k0 + 16 * kq;
    const float* p0 = cm.colptr(n0 + 4 * nq); const float* p1 = cm.colptr(n0 + 4 * nq + 1); const float* p2 = cm.colptr(n0 + 4 * nq + 2); const float* p3 = cm.colptr(n0 + 4 * nq + 3);
    const bool vec = p0 && p1 == p0 + 1 && p2 == p0 + 2 && p3 == p0 + 3 && (((uintptr_t)p0) & 15) == 0;
    f32x4 v[16];
    if (vec) {
#pragma unroll
        for (int i = 0; i < 16; ++i) v[i] = *(const f32x4*)(p0 + (size_t)(kb + i) * ldw);
    } else {
#pragma unroll
        for (int i = 0; i < 16; ++i) { const size_t o = (size_t)(kb + i) * ldw; v[i] = (f32x4){p0 ? p0[o] : 0.f, p1 ? p1[o] : 0.f, p2 ? p2[o] : 0.f, p3 ? p3[o] : 0.f}; }
    }
    if (kscale) {
#pragma unroll
        for (int i = 0; i < 16; ++i) v[i] = v[i] * kscale[kb + i];
    }
#pragma unroll
    for (int j = 0; j < 4; ++j) {
        u32x4 lo, hi;
        lo.x = cvt_pk_bf16(v[0][j], v[1][j]); lo.y = cvt_pk_bf16(v[2][j], v[3][j]); lo.z = cvt_pk_bf16(v[4][j], v[5][j]); lo.w = cvt_pk_bf16(v[6][j], v[7][j]);
        hi.x = cvt_pk_bf16(v[8][j], v[9][j]); hi.y = cvt_pk_bf16(v[10][j], v[11][j]); hi.z = cvt_pk_bf16(v[12][j], v[13][j]); hi.w = cvt_pk_bf16(v[14][j], v[15][j]);
        LAS unsigned char* d = scr + (4 * nq + j) * 144 + kq * 32;
        *(LAS u32x4*)d = lo; *(LAS u32x4*)(d + 16) = hi;
    }
    LDS_WAIT(); asm volatile("" ::: "memory");
#pragma unroll
    for (int it = 0; it < 8; ++it) { const int r = 8 * it + (lane >> 3), c = lane & 7;
        *(u32x4*)(WT + (size_t)(n0 + r) * ldt + k0 + 8 * c) = *(const LAS u32x4*)(scr + r * 144 + c * 16); }
    LDS_WAIT(); asm volatile("" ::: "memory");
}
template <class CM>
__device__ __forceinline__ void cvt_item8(const CM& cm, int ldw, float scale, unsigned char* WT8, int ldt, LAS unsigned char* scr, int k0, int n0, int lane, const float* kscale = nullptr) {
    const int kq = lane >> 4, nq = lane & 15, kb = k0 + 16 * kq;
    const float* p0 = cm.colptr(n0 + 4 * nq); const float* p1 = cm.colptr(n0 + 4 * nq + 1); const float* p2 = cm.colptr(n0 + 4 * nq + 2); const float* p3 = cm.colptr(n0 + 4 * nq + 3);
    const bool vec = p0 && p1 == p0 + 1 && p2 == p0 + 2 && p3 == p0 + 3 && (((uintptr_t)p0) & 15) == 0;
    f32x4 v[16];
    if (vec) {
#pragma unroll
        for (int i = 0; i < 16; ++i) v[i] = *(const f32x4*)(p0 + (size_t)(kb + i) * ldw);
    } else {
#pragma unroll
        for (int i = 0; i < 16; ++i) { const size_t o = (size_t)(kb + i) * ldw; v[i] = (f32x4){p0 ? p0[o] : 0.f, p1 ? p1[o] : 0.f, p2 ? p2[o] : 0.f, p3 ? p3[o] : 0.f}; }
    }
    if (kscale) {
#pragma unroll
        for (int i = 0; i < 16; ++i) v[i] = v[i] * kscale[kb + i];
    }
#pragma unroll
    for (int j = 0; j < 4; ++j) {
        u32x4 w;
        w.x = cvt_pk4_fp8(v[0][j] * scale, v[1][j] * scale, v[2][j] * scale, v[3][j] * scale); w.y = cvt_pk4_fp8(v[4][j] * scale, v[5][j] * scale, v[6][j] * scale, v[7][j] * scale);
        w.z = cvt_pk4_fp8(v[8][j] * scale, v[9][j] * scale, v[10][j] * scale, v[11][j] * scale); w.w = cvt_pk4_fp8(v[12][j] * scale, v[13][j] * scale, v[14][j] * scale, v[15][j] * scale);
        *(LAS u32x4*)(scr + (4 * nq + j) * 80 + kq * 16) = w;
    }
    LDS_WAIT(); asm volatile("" ::: "memory");
#pragma unroll
    for (int it = 0; it < 4; ++it) { const int r = 16 * it + (lane >> 2), c = lane & 3;
        *(u32x4*)(WT8 + (size_t)(n0 + r) * ldt + k0 + 16 * c) = *(const LAS u32x4*)(scr + r * 80 + c * 16); }
    LDS_WAIT(); asm volatile("" ::: "memory");
}
__device__ __forceinline__ int rope_src(int s) { return (s >> 5) * 32 + (s & 1) * 16 + ((s & 31) >> 1); }
struct CM_Id { const float* W; __device__ __forceinline__ const float* colptr(int n) const { return W + n; } };
struct CM_W1 { const float* W;
    __device__ __forceinline__ const float* colptr(int n) const { if (n < 2048) return W + n; if (n < 6144) return W + n + 64; if (n < 6208) return W + 2048 + rope_src(n - 6144); return nullptr; } };
struct CM_Q { const float* W;
    __device__ __forceinline__ const float* colptr(int n) const { if (n < 2048) return W + (n >> 7) * 192 + (n & 127); const int r = n - 2048; return W + (r >> 6) * 192 + 128 + rope_src(r & 63); } };
struct CM_KV { const float* W;
    __device__ __forceinline__ const float* colptr(int n) const { const int v = n >> 11, r = n & 2047; return W + (r >> 7) * 256 + v * 128 + (r & 127); } };
struct CM_GU { const float* Wg; const float* Wu;
    __device__ __forceinline__ const float* colptr(int n) const { const int q = n >> 3, j = n & 7; return j < 4 ? Wg + 4 * q + j : Wu + 4 * q + j - 4; } };

__device__ __forceinline__ void phase0(const Args& a, LAS unsigned char* lds) {
    const int tid = threadIdx.x, lane = tid & 63, wave = tid >> 6, G = gridDim.x;
    const int gtid = blockIdx.x * 512 + tid, NTH = G * 512, gw = blockIdx.x * 8 + wave, NGW = G * 8;
    unsigned char* ws = a.ws;
    LAS float* S = (LAS float*)lds;
    LAS float* RED = (LAS float*)(lds + 40960);
    for (int i = tid; i < 5 * 2048; i += 512) { const int r = i >> 11, k = i & 2047; const float v = r < 4 ? a.in[1][r * 2048 + k] : a.in[3][k]; S[i] = v * sigmoidf_(v); }
    __syncthreads();
    float* MOD = (float*)(ws + WS_MOD);
    for (int item = blockIdx.x; item < NMODC / 64; item += G) {
        const int cg = tid & 15, ks = tid >> 4, n = item * 64 + 4 * cg;
        f32x4 acc[5];
#pragma unroll
        for (int r = 0; r < 5; ++r) acc[r] = (f32x4){0.f, 0.f, 0.f, 0.f};
        const float* wp = a.in[4] + (size_t)(ks * 64) * NMODC + n;
#pragma unroll 16
        for (int kk = 0; kk < 64; ++kk) { const f32x4 w = *(const f32x4*)(wp + (size_t)kk * NMODC); const int k = ks * 64 + kk;
#pragma unroll
            for (int r = 0; r < 5; ++r) acc[r] += w * S[r * 2048 + k]; }
#pragma unroll
        for (int r = 0; r < 5; ++r)
#pragma unroll
            for (int j = 0; j < 4; ++j) RED[(ks * 5 + r) * 64 + 4 * cg + j] = acc[r][j];
        __syncthreads();
        if (tid < 320) { const int r = tid >> 6, cn = tid & 63; float s = 0.f;
            for (int q = 0; q < 32; ++q) s += RED[(q * 5 + r) * 64 + cn];
            MOD[r * NMODC + item * 64 + cn] = s + a.in[5][item * 64 + cn]; }
        __syncthreads();
    }
    __syncthreads();
    if (gtid < 64 * 16) { const int pos = gtid >> 4, f = gtid & 15; const float freq = 1.0f / powf(10000.0f, (float)f / 16.0f); const float ang = (float)pos * freq;
        float* cs = (float*)(ws + WS_CS); cs[gtid * 2] = cosf(ang); cs[gtid * 2 + 1] = sinf(ang); }
    { bf16_t* PW = (bf16_t*)(ws + WS_PW); const float* pw = a.in[11];
      for (int i = gtid; i < 4 * 256 * 256 / 4; i += NTH) { const f32x4 v = *(const f32x4*)(pw + 4 * (size_t)i); u32x2 o; o.x = pk2(v[0], v[1]); o.y = pk2(v[2], v[3]); *(u32x2*)(PW + 4 * (size_t)i) = o; }
      bf16_t* WRH = (bf16_t*)(ws + WS_WRH); bf16_t* WRL = (bf16_t*)(ws + WS_WRL);
      for (int i = gtid; i < 64 * 2048; i += NTH) { const int n = i >> 11, k = i & 2047; float v = 0.f;
          if (n < 32) v = a.in[22][k * 32 + n]; else if (n < 36) v = a.in[20][k * 4 + (n - 32)];
          const unsigned h = f2bf(v); const float lo = v - __uint_as_float(h << 16); WRH[i] = (bf16_t)h; WRL[i] = (bf16_t)f2bf(lo); } }
    LAS unsigned char* scr = lds + wave * 16384;
    constexpr int I0 = 32 * (N1 / 64), I1 = 8 * (NQ / 64), I2 = 8 * (NKV / 64), I3 = 16 * 32, I4 = 32 * 32, I5 = 32 * 32;
    constexpr int NIT = I0 + I1 + I2 + I3 + I4 + I5;
    (void)I1; (void)I2; (void)I3; (void)I4; (void)I5; (void)NIT;
    for (int it = gw; it < I0; it += NGW) { const int nb = N1 / 64; cvt_item8(CM_W1{a.in[10]}, 6208, 32.0f, (unsigned char*)(ws + WS_W1T), 2048, scr, 64 * (it / nb), 64 * (it % nb), lane); }
}
__device__ __forceinline__ void late_weights(const Args& a, LAS unsigned char* lds, int pi, int np) {
    const int tid = threadIdx.x, lane = tid & 63, wave = tid >> 6; unsigned char* ws = a.ws;
    LAS unsigned char* scr = lds + wave * 16384;
    constexpr int I1 = 8 * (NQ / 64), I2 = 8 * (NKV / 64), I3 = 16 * 32, I4 = 32 * 32, I5 = 32 * 32;
    for (int it = pi * 8 + wave; it < I1 + I2 + I3 + I4 + I5; it += np * 8) {
        int r = it;
        if (r < I3) { cvt_item(CM_Id{a.in[13]}, DM, a.in[12], (bf16_t*)(ws + WS_BPT), 1024, scr, 64 * (r / 32), 64 * (r % 32), lane); continue; } r -= I3;
        if (r < I1) { const int nb = NQ / 64; cvt_item8(CM_Q{a.in[15]}, NQ, 16.0f, (unsigned char*)(ws + WS_WQT), 512, scr, 64 * (r / nb), 64 * (r % nb), lane, a.in[14]); continue; } r -= I1;
        if (r < I2) { const int nb = NKV / 64; cvt_item8(CM_KV{a.in[17]}, NKV, 16.0f, (unsigned char*)(ws + WS_WKVT), 512, scr, 64 * (r / nb), 64 * (r % nb), lane, a.in[16]); continue; } r -= I2;
        if (r < I4) { cvt_item8(CM_Id{a.in[18]}, DM, 32.0f, (unsigned char*)(ws + WS_WOT), 2048, scr, 64 * (r / 32), 64 * (r % 32), lane); continue; } r -= I4;
        cvt_item8(CM_Id{a.in[19]}, DM, 32.0f, (unsigned char*)(ws + WS_WOUTT), 2048, scr, 64 * (r / 32), 64 * (r % 32), lane);
    }
}
__device__ __forceinline__ void phase1(const Args& a, LAS unsigned char* lds) {
    const int tid = threadIdx.x, lane = tid & 63, wave = tid >> 6, G = gridDim.x, gw = blockIdx.x * 8 + wave, NGW = G * 8;
    unsigned char* ws = a.ws; const float* MOD = (const float*)(ws + WS_MOD); const float* gpre = a.in[6]; bf16_t* H = (bf16_t*)(ws + WS_H);
    for (int m = gw; m < TA; m += NGW) {
        const float* xrow; const float* sh;
        if (m < T) { xrow = a.in[0] + (size_t)m * DM; sh = MOD + (m >> 12) * NMODC; } else { xrow = a.in[2] + (size_t)(m - T) * DM; sh = MOD + 4 * NMODC; }
        const float* sc = sh + 2048;
        f32x4 v[8]; float s = 0.f;
#pragma unroll
        for (int j = 0; j < 8; ++j) { v[j] = ((const f32x4*)xrow)[lane + 64 * j]; s += pg8::sq4(v[j]); }
        const float r = rsqrtf(wave_sum(s) * (1.0f / DM) + EPS);
        unsigned* o4 = (unsigned*)((unsigned char*)H + (size_t)m * DM) + lane;
#pragma unroll
        for (int j = 0; j < 8; ++j) { const f32x4 g = ((const f32x4*)gpre)[lane + 64 * j], c = ((const f32x4*)sc)[lane + 64 * j], h = ((const f32x4*)sh)[lane + 64 * j];
            const f32x4 y = v[j] * r * g * (c + 1.0f) + h; o4[64 * j] = cvt_pk4_fp8(y[0], y[1], y[2], y[3]); }
    }
    __syncthreads();
}
template <int HW>
__device__ __forceinline__ void pool_diff_item(const bf16_t* U, bf16_t* P, int t, int ch) {
    const int l = t & 4095, base = t - l;
    f32x4 s0 = {0.f, 0.f, 0.f, 0.f}, s1 = s0; u32x4 w[2 * HW];
#pragma unroll
    for (int k = 0; k < 2 * HW; ++k) { int tt = l - HW + k; tt = tt < 0 ? 0 : (tt > 4095 ? 4095 : tt); w[k] = *(const u32x4*)(U + (size_t)(base + tt) * 1024 + ch * 8); }
#pragma unroll
    for (int k = 0; k < 2 * HW; ++k) { const int tt = l - HW + k; const float v = (tt >= 0 && tt < 4096) ? 1.f : 0.f; f32x4 x0, x1; pg8::unpack8(w[k], x0, x1); s0 += x0 * v; s1 += x1 * v; }
    const int lo = l - HW < 0 ? 0 : l - HW, hi = l + HW > 4096 ? 4096 : l + HW; const float inv = 1.0f / (float)(hi - lo);
    f32x4 u0, u1; pg8::unpack8(w[HW], u0, u1);
    { const f32x4 d0 = (s0 * inv - u0) * 8.0f, d1 = (s1 * inv - u1) * 8.0f; u32x2 w8; w8.x = cvt_pk4_fp8(d0[0], d0[1], d0[2], d0[3]); w8.y = cvt_pk4_fp8(d1[0], d1[1], d1[2], d1[3]);
      *(u32x2*)((unsigned char*)P + (size_t)t * 1024 + ch * 8) = w8; }
}
__device__ __forceinline__ void pool_diff_pass(const Args& a) {
    const int gtid = blockIdx.x * 512 + opaque_tid(), NTH = gridDim.x * 512;
    const bf16_t* U = (const bf16_t*)(a.ws + WS_POOLIN); bf16_t* P = (bf16_t*)(a.ws + WS_POOLED);
    for (int item = gtid; item < T * 128; item += NTH) {
        const int c = item & 31, t = (item >> 5) & (T - 1), g = item >> 19, ch = g * 32 + c;
        if (g == 0) pool_diff_item<1>(U, P, t, ch); else if (g == 1) pool_diff_item<2>(U, P, t, ch); else if (g == 2) pool_diff_item<4>(U, P, t, ch); else pool_diff_item<8>(U, P, t, ch);
    }
}
__device__ __forceinline__ void kr_rope_pass(const Args& a) {
    const int gtid = blockIdx.x * 512 + opaque_tid(), NTH = gridDim.x * 512;
    const bf16_t* K2 = (const bf16_t*)(a.ws + WS_KR2); bf16_t* KR = (bf16_t*)(a.ws + WS_KR); const float* cs = (const float*)(a.ws + WS_CS);
    for (int item = gtid; item < TA * 8; item += NTH) { const int row = item >> 3, ch = item & 7;
        f32x4 v0, v1; pg8::unpack8(*(const u32x4*)(K2 + (size_t)row * 256 + ch * 8), v0, v1);
        if (row < T) { const int l = row & 4095, pos = (ch >> 2) ? (l & 63) : (l >> 6); pg8::rope8(v0, v1, cs + (pos * 16 + 4 * (ch & 3)) * 2); }
        u32x2 w8; w8.x = cvt_pk4_fp8(v0[0], v0[1], v0[2], v0[3]); w8.y = cvt_pk4_fp8(v1[0], v1[1], v1[2], v1[3]); *(u32x2*)((unsigned char*)KR + (size_t)row * 64 + ch * 8) = w8; }
}
template <int WHICH>
__device__ __forceinline__ void moe_cvt(const Args& a, LAS unsigned char* lds, int pi, int np) {
    const int tid = threadIdx.x, lane = tid & 63, wave = __builtin_amdgcn_readfirstlane(tid >> 6); unsigned char* ws = a.ws;
    LAS unsigned char* scr = lds + wave * 16384; const int gw = pi * 8 + wave, NGW = np * 8;
    constexpr int IGU = 32 * 16, IDN = 8 * 32;
    for (int it = (WHICH ? NEXP * IGU : 0) + gw; it < (WHICH ? NEXP * (IGU + IDN) : NEXP * IGU); it += NGW) {
        if (it < NEXP * IGU) { const int e = it / IGU, r = it % IGU;
            cvt_item8(CM_GU{a.in[24] + (size_t)e * DM * DE, a.in[25] + (size_t)e * DM * DE}, DE, 32.0f, (unsigned char*)(ws + WS_WGU) + (size_t)e * 1024 * DM, DM, scr, 64 * (r / 16), 64 * (r % 16), lane); }
        else { const int q = it - NEXP * IGU, e = q / IDN, r = q % IDN;
            cvt_item8(CM_Id{a.in[26] + (size_t)e * DE * DM}, DM, 16.0f, (unsigned char*)(ws + WS_WD) + (size_t)e * DM * DE, DE, scr, 64 * (r / 32), 64 * (r % 32), lane); } }
}
__device__ __forceinline__ void phase7(const Args& a, LAS unsigned char* lds) {
    const int tid = threadIdx.x, lane = tid & 63, wave = __builtin_amdgcn_readfirstlane(tid >> 6), G = gridDim.x;
    unsigned char* ws = a.ws;
    constexpr int PITCH = 520;
    LAS bf16_t* THI = (LAS bf16_t*)lds; LAS bf16_t* TLO = THI + 32 * PITCH;
    LAS float* RED = (LAS float*)lds;
    LAS float* LOG = (LAS float*)(lds + 66560);
    LAS unsigned* cntl = (LAS unsigned*)(lds + MISC_OFF + 256);
    if (tid < 32) cntl[tid] = 0u;
    __syncthreads();
    const float* x = a.in[0]; bf16_t* X1B = (bf16_t*)(ws + WS_X1B); const float* MOD = (const float*)(ws + WS_MOD);
    const bf16_t* YX = (const bf16_t*)(ws + WS_YX); bf16_t* H2 = (bf16_t*)(ws + WS_H2);
    const bf16_t* WRH = (const bf16_t*)(ws + WS_WRH); const bf16_t* WRL = (const bf16_t*)(ws + WS_WRL);
    f32x2* TW = (f32x2*)(ws + WS_TW);
    LAS i32x4* tis = (LAS i32x4*)(lds + 73728);
    LAS unsigned* basel = (LAS unsigned*)(lds + MISC_OFF + 384);
    int tl = -1;
    for (int tile = blockIdx.x; tile < T / 32; tile += G) {
        ++tl;
        float r2[4];
#pragma unroll
        for (int rr = 0; rr < 4; ++rr) {
            const int t = tile * 32 + wave * 4 + rr; const float* mod = MOD + (t >> 12) * NMODC;
            f32x4 yv[8]; float sp = 0.f;
#pragma unroll
            for (int j = 0; j < 8; ++j) { const u32x2 yw = ((const u32x2*)(YX + (size_t)t * DM))[lane + 64 * j]; yv[j] = (f32x4){bflo(yw.x), bfhi(yw.x), bflo(yw.y), bfhi(yw.y)}; sp += pg8::sq4(yv[j]); }
            const float r1 = rsqrtf(wave_sum(sp) * (1.0f / DM) + EPS);
            float s1 = 0.f;
#pragma unroll
            for (int j = 0; j < 8; ++j) { const int k4 = lane + 64 * j;
                const f32x4 y = yv[j];
                const f32x4 xv = ((const f32x4*)(x + (size_t)t * DM))[k4], gp = ((const f32x4*)a.in[7])[k4], g1 = ((const f32x4*)(mod + 4096))[k4];
                const f32x4 x1 = xv + g1 * (y * r1 * gp); ((u32x2*)(X1B + (size_t)t * DM))[k4] = (u32x2){pk2(x1[0], x1[1]), pk2(x1[2], x1[3])}; s1 += pg8::sq4(x1); }
            r2[rr] = rsqrtf(wave_sum(s1) * (1.0f / DM) + EPS);
        }
        f32x16 C0 = {}, C1 = {};
        for (int c = 0; c < 4; ++c) {
            if (c > 0) __syncthreads();
#pragma unroll
            for (int rr = 0; rr < 4; ++rr) {
                const int t = tile * 32 + wave * 4 + rr; const float* mod = MOD + (t >> 12) * NMODC;
#pragma unroll
                for (int jj = 0; jj < 2; ++jj) { const int k4 = lane + 64 * (2 * c + jj);
                    const u32x2 xw = ((const u32x2*)(X1B + (size_t)t * DM))[k4]; const f32x4 x1 = (f32x4){bflo(xw.x), bfhi(xw.x), bflo(xw.y), bfhi(xw.y)}, gn = ((const f32x4*)a.in[8])[k4], sc2 = ((const f32x4*)(mod + 8192))[k4], sh2 = ((const f32x4*)(mod + 6144))[k4];
                    const f32x4 h = x1 * r2[rr] * gn * (sc2 + 1.0f) + sh2;
                    u32x2 wh, wl; { const unsigned h0 = f2bf(h[0]), h1 = f2bf(h[1]), h2 = f2bf(h[2]), h3 = f2bf(h[3]);
                        wh.x = h0 | (h1 << 16); wh.y = h2 | (h3 << 16);
                        wl.x = pk2(h[0] - __uint_as_float(h0 << 16), h[1] - __uint_as_float(h1 << 16)); wl.y = pk2(h[2] - __uint_as_float(h2 << 16), h[3] - __uint_as_float(h3 << 16)); }
                    ((unsigned*)((unsigned char*)H2 + (size_t)t * DM))[k4] = cvt_pk4_fp8(h[0], h[1], h[2], h[3]);
                    *(LAS u32x2*)(THI + (wave * 4 + rr) * PITCH + 4 * lane + 256 * jj) = wh; *(LAS u32x2*)(TLO + (wave * 4 + rr) * PITCH + 4 * lane + 256 * jj) = wl; }
            }
            __syncthreads();
#pragma unroll
            for (int ks = 0; ks < 4; ++ks) { const int kk = (wave * 4 + ks) * 16 + (lane >> 5) * 8, kg = c * 512 + kk;
                const bf16x8 Bh = *(const LAS bf16x8*)(THI + (lane & 31) * PITCH + kk), Bl = *(const LAS bf16x8*)(TLO + (lane & 31) * PITCH + kk);
                const bf16x8 A0h = *(const bf16x8*)(WRH + (size_t)(lane & 31) * DM + kg), A0l = *(const bf16x8*)(WRL + (size_t)(lane & 31) * DM + kg);
                const bf16x8 A1h = *(const bf16x8*)(WRH + (size_t)(32 + (lane & 31)) * DM + kg), A1l = *(const bf16x8*)(WRL + (size_t)(32 + (lane & 31)) * DM + kg);
                C0 = __builtin_amdgcn_mfma_f32_32x32x16_bf16(A0h, Bh, C0, 0, 0, 0); C0 = __builtin_amdgcn_mfma_f32_32x32x16_bf16(A0h, Bl, C0, 0, 0, 0); C0 = __builtin_amdgcn_mfma_f32_32x32x16_bf16(A0l, Bh, C0, 0, 0, 0);
                C1 = __builtin_amdgcn_mfma_f32_32x32x16_bf16(A1h, Bh, C1, 0, 0, 0); C1 = __builtin_amdgcn_mfma_f32_32x32x16_bf16(A1h, Bl, C1, 0, 0, 0); C1 = __builtin_amdgcn_mfma_f32_32x32x16_bf16(A1l, Bh, C1, 0, 0, 0); }
        }
        __syncthreads();
        { const int hi = lane >> 5, j = lane & 31;
#pragma unroll
          for (int r = 0; r < 16; ++r) { const int e = att::crow(r, hi); RED[(wave * 64 + e) * 32 + j] = C0[r]; RED[(wave * 64 + 32 + e) * 32 + j] = C1[r]; } }
        __syncthreads();
        for (int i = tid; i < 36 * 32; i += 512) { const int e = i >> 5, j = i & 31; float s = 0.f;
#pragma unroll
            for (int w = 0; w < 8; ++w) s += RED[(w * 64 + e) * 32 + j];
            LOG[i] = s + (e < 32 ? a.in[23][e] : a.in[21][e - 32]); }
        __syncthreads();
        if (tid < 32) { const int j = tid, t = tile * 32 + j;
            float gm = LOG[32 * 32 + j]; int gi = 0;
#pragma unroll
            for (int q = 1; q < 4; ++q) { const float v = LOG[(32 + q) * 32 + j]; if (v > gm) { gm = v; gi = q; } }
            float gs = 0.f;
#pragma unroll
            for (int q = 0; q < 4; ++q) gs += __expf(LOG[(32 + q) * 32 + j] - gm);
            const float pg = 1.0f / gs;
            float b1 = LOG[(gi * 8) * 32 + j]; int i1 = 0;
#pragma unroll
            for (int q = 1; q < 8; ++q) { const float v = LOG[(gi * 8 + q) * 32 + j]; if (v > b1) { b1 = v; i1 = q; } }
            float b2 = -3.0e38f; int i2 = 0;
#pragma unroll
            for (int q = 0; q < 8; ++q) { const float v = LOG[(gi * 8 + q) * 32 + j]; if (q != i1 && v > b2) { b2 = v; i2 = q; } }
            const float p1 = __expf(b2 - b1), w0 = pg / (1.0f + p1), w1 = pg * p1 / (1.0f + p1);
            const int e0 = gi * 8 + i1, e1 = gi * 8 + i2;
            const unsigned lp0 = __hip_atomic_fetch_add(&cntl[e0], 1u, __ATOMIC_RELAXED, __HIP_MEMORY_SCOPE_WORKGROUP), lp1 = __hip_atomic_fetch_add(&cntl[e1], 1u, __ATOMIC_RELAXED, __HIP_MEMORY_SCOPE_WORKGROUP);
            tis[tl * 32 + j] = (i32x4){e0, e1, (int)lp0, (int)lp1}; TW[t] = (f32x2){w0, w1}; }
        __syncthreads();
    }
    if (tid < 32) { const unsigned n = cntl[tid]; unsigned base = 0u;
        if (n) base = __hip_atomic_fetch_add((unsigned*)(ws + WS_CTL) + CW_CNT + 64 * tid, n, RLX_AGENT);
        basel[tid] = base; }
    __syncthreads();
    { int* RM = (int*)(ws + WS_ROWMAP2);
      for (int i = tid; i < (tl + 1) * 32; i += 512) { const i32x4 ti = tis[i]; const int t = ((int)blockIdx.x + (i >> 5) * G) * 32 + (i & 31);
          RM[ti.x * RM_CAP + (int)basel[ti.x] + ti.z] = 2 * t; RM[ti.y * RM_CAP + (int)basel[ti.y] + ti.w] = 2 * t + 1; } }
    __syncthreads();
}
__device__ __forceinline__ void build_cum(const Args& a, LAS int* cum) {
    if (threadIdx.x == 0) { int s = 0; const unsigned* cnt = (const unsigned*)(a.ws + WS_CTL) + CW_CNT;
        for (int e = 0; e < NEXP; ++e) { cum[e] = s; const unsigned c = __hip_atomic_load(cnt + 64 * e, RLX_AGENT); s += (int)((c + 255u) >> 8); } cum[NEXP] = s; }
    __syncthreads();
}
__device__ __forceinline__ void phase8(const Args& a, LAS unsigned char* lds) {
    const int tid = threadIdx.x, G = gridDim.x, gtid = blockIdx.x * 512 + tid, NTH = G * 512;
    unsigned char* ws = a.ws; LAS int* cum = (LAS int*)(lds + MISC_OFF + 512);
    build_cum(a, cum);
    int* ROWMAP = (int*)(ws + WS_ROWMAP); const unsigned* cnt = (const unsigned*)(ws + WS_CTL) + CW_CNT;
    for (int i = gtid; i < NEXP * 256; i += NTH) { const int e = i >> 8, j = i & 255; const int c = (int)__hip_atomic_load(cnt + 64 * e, RLX_AGENT); const int pc = (c + 255) & ~255;
        if (c + j < pc) ROWMAP[cum[e] * 256 + c + j] = -1; }
    const i32x4* TI = (const i32x4*)(ws + WS_TI); const unsigned* BLKB = (const unsigned*)(ws + WS_BLKB);
    for (int t = gtid; t < T; t += NTH) { const i32x4 ti = TI[t]; const int blk = (t >> 5) % G;
        ROWMAP[cum[ti.x] * 256 + (int)BLKB[blk * 32 + ti.x] + ti.z] = 2 * t; ROWMAP[cum[ti.y] * 256 + (int)BLKB[blk * 32 + ti.y] + ti.w] = 2 * t + 1; }
}
__device__ __forceinline__ void phase11(const Args& a) {
    const int tid = threadIdx.x, lane = tid & 63, wave = tid >> 6, gw = blockIdx.x * 8 + wave, NGW = gridDim.x * 8;
    const bf16_t* Y2 = (const bf16_t*)(a.ws + WS_Y2); const bf16_t* X1B = (const bf16_t*)(a.ws + WS_X1B); const float* MOD = (const float*)(a.ws + WS_MOD); float* out = a.out;
    for (int t = gw; t < T; t += NGW) { const float* mod = MOD + (t >> 12) * NMODC;
        f32x4 y[8]; float s = 0.f;
#pragma unroll
        for (int j = 0; j < 8; ++j) { const int k4 = lane + 64 * j; const int p = ((const int*)((const unsigned char*)Y2 + (size_t)t * DM))[k4], q = ((const int*)((const unsigned char*)Y2 + (size_t)(T + t) * DM))[k4];
            const f32x2 p0 = __builtin_amdgcn_cvt_pk_f32_fp8(p, false), p1 = __builtin_amdgcn_cvt_pk_f32_fp8(p, true), q0 = __builtin_amdgcn_cvt_pk_f32_fp8(q, false), q1 = __builtin_amdgcn_cvt_pk_f32_fp8(q, true);
            y[j] = (f32x4){p0[0] + q0[0], p0[1] + q0[1], p1[0] + q1[0], p1[1] + q1[1]} * 0.125f; s += pg8::sq4(y[j]); }
        const float r = rsqrtf(wave_sum(s) * (1.0f / DM) + EPS);
#pragma unroll
        for (int j = 0; j < 8; ++j) { const int k4 = lane + 64 * j; const f32x4 gp = ((const f32x4*)a.in[9])[k4], g2 = ((const f32x4*)(mod + 10240))[k4];
            const u32x2 xw = ((const u32x2*)(X1B + (size_t)t * DM))[k4]; const f32x4 x1 = (f32x4){bflo(xw.x), bfhi(xw.x), bflo(xw.y), bfhi(xw.y)};
            ((f32x4*)(out + (size_t)t * DM))[k4] = x1 + g2 * (y[j] * r * gp); } }
}

__global__ void __launch_bounds__(512, 2) fwd(Args args) {
    extern __shared__ __attribute__((aligned(16))) unsigned char lds_raw[];
    LAS unsigned char* lds = (LAS unsigned char*)lds_raw;
    const int tid = threadIdx.x, G = gridDim.x;
    unsigned char* ws = args.ws;
    for (int u = opaque_tid(); u < (LDS_BYTES - MISC_OFF) / 4; u += 512) ((LAS unsigned*)(lds + MISC_OFF))[u] = 0u;
    __syncthreads();
    const int lo = args.ph_lo, hi = args.ph_hi;
    XcdBarrier bar; bar.bar = (unsigned*)(ws + WS_CTL) + CW_BAR; bar.x = 0; bar.st = nullptr;
    if (hi - lo > 1) bar = xcd_barrier_post((unsigned*)(ws + WS_CTL) + CW_BAR, (volatile LAS unsigned*)(lds + MISC_OFF));
    const int vcu = (G % 8 == 0) ? ((int)blockIdx.x % 8) * (G / 8) + (int)blockIdx.x / 8 : (int)blockIdx.x;

#define IN(k) (lo <= (k) && (k) < hi)
#define SEAM(k) do { if (IN(k) && IN((k) + 1)) xcd_barrier(bar); } while (0)
    if (IN(0)) { phase0(args, lds); } SEAM(0);
    if (IN(1)) { phase1(args, lds); } SEAM(1);
    if (IN(2)) {
        pg8::Gemm g{(const bf16_t*)(ws + WS_H), (const bf16_t*)(ws + WS_W1T), 1024, 1024, 1024, nullptr, 122}; pg8::Gemm1Order S{G, (int)blockIdx.x};
        pg8::EpiG1 E{(bf16_t*)(ws + WS_POOLIN), (bf16_t*)(ws + WS_QC), (bf16_t*)(ws + WS_KVC), (bf16_t*)(ws + WS_KR2), (bf16_t*)(ws + WS_GATES), (float*)(ws + WS_SSQQ), (float*)(ws + WS_SSQKV), (const float*)(ws + WS_CS)};
        pg8::gemm_phase<pg8::EpiG1, pg8::Gemm1Order, PG8_ALIGN, PG8_SP2, false, true>(lds, g, S, E);
        { const int nfull = 1612 % G;
          if ((int)blockIdx.x >= nfull) { __syncthreads(); late_weights(args, lds, (int)blockIdx.x - nfull, G - nfull); __syncthreads(); } }
    } SEAM(2);
    if (IN(3)) {
        { pg8::Gemm g{(const bf16_t*)(ws + WS_QC), (const bf16_t*)(ws + WS_WQT), 256, 256, 256, nullptr, 123};
          pg8::StaticOrder S; S.init(64, 12, G, (int)blockIdx.x);
          pg8::EpiQ E{(bf16_t*)(ws + WS_Q), (const float*)(ws + WS_SSQQ), (const float*)(ws + WS_CS)};
          pg8::gemm_phase<pg8::EpiQ, pg8::StaticOrder, PG8_ALIGN, PG8_SP2, false, true>(lds, g, S, E); }
        { pg8::Gemm g{(const bf16_t*)(ws + WS_KVC), (const bf16_t*)(ws + WS_WKVT), 256, 256, 256, nullptr, 123};
          pg8::StaticOrder S; S.init(68, 8, G, (int)((blockIdx.x + G - 64) % G));
          pg8::EpiK E{(unsigned char*)(ws + WS_KV), (const float*)(ws + WS_SSQKV)};
          pg8::gemm_phase<pg8::EpiK, pg8::StaticOrder, PG8_ALIGN, PG8_SP2, false, true>(lds, g, S, E); }
        {
          LAS float* rkt = (LAS float*)(lds + MISC_OFF + 4096); pg8::VtOrder S{G, (int)((blockIdx.x + 128) % G)};
          { const float* ssq = (const float*)(ws + WS_SSQKV); pg8::Unit uu;
            const int tid = opaque_tid();
            for (int i = 0; i < 8; ++i) { if (!S.next(i, uu)) break; if (tid < 256) { const f32x4 a = *(const f32x4*)(ssq + (size_t)(uu.pn * 256 + tid) * 8), b2 = *(const f32x4*)(ssq + (size_t)(uu.pn * 256 + tid) * 8 + 4);
                rkt[i * 256 + tid] = rsqrtf(((a[0] + a[1]) + (a[2] + a[3]) + (b2[0] + b2[1]) + (b2[2] + b2[3])) * (1.0f / 512.0f) + EPS); } }
            __syncthreads(); }
          pg8::Gemm g{(const bf16_t*)((const unsigned char*)(ws + WS_WKVT) + (size_t)2048 * 512), (const bf16_t*)(ws + WS_KVC), 256, 256, 256, nullptr, 127, 123};
          pg8::EpiVT E{(unsigned char*)(ws + WS_VB), rkt};
          pg8::gemm_phase<pg8::EpiVT, pg8::VtOrder, PG8_ALIGN, PG8_SP2, false, true>(lds, g, S, E); }
        { pg8::Gemm g{(const bf16_t*)(ws + WS_BPT), (const bf16_t*)(ws + WS_PW), 256, 1024, 256}; pg8::FoldOrder S{G, (int)((blockIdx.x + G - 160 % G) % G)};
          pg8::EpiPlain8 E{(unsigned char*)(ws + WS_WPPT), 1024, 32.0f};
          pg8::gemm_phase<pg8::EpiPlain8, pg8::FoldOrder, PG8_ALIGN, false>(lds, g, S, E); }
        pool_diff_pass(args);
        kr_rope_pass(args);
    } SEAM(3);
    if (IN(4)) {
        for (int u = vcu; u < 1024; u += G) { const int qb = u & 15, h = (u >> 4) & 15, b = u >> 8;
            att::attn_unit((const unsigned char*)(ws + WS_Q), (const unsigned char*)(ws + WS_KV), (const unsigned char*)(ws + WS_VB), (const unsigned char*)(ws + WS_KR), (bf16_t*)(ws + WS_ATT), b, h, qb, (char*)lds_raw); }
    } SEAM(4);
    if (IN(5)) {
        if (!(blockIdx.x & 1)) { moe_cvt<0>(args, lds, (int)blockIdx.x, G); __syncthreads(); }
        { pg8::Gemm g{(const bf16_t*)(ws + WS_POOLED), (const bf16_t*)(ws + WS_WPPT), 512, 512, 512, nullptr, 122, 124}; pg8::StaticOrder S; S.init(64, 8, G, (int)blockIdx.x);
          pg8::EpiGate<false> E{(bf16_t*)(ws + WS_T1), nullptr, (const bf16_t*)(ws + WS_GATES), 0};
          pg8::gemm_phase<pg8::EpiGate<false>, pg8::StaticOrder, PG8_ALIGN, PG8_SP2, false, true>(lds, g, S, E); }
        if (blockIdx.x & 1) { moe_cvt<0>(args, lds, (int)blockIdx.x, G); __syncthreads(); }
        { pg8::Gemm g{(const bf16_t*)(ws + WS_ATT), (const bf16_t*)(ws + WS_WOT), 1024, 1024, 1024, nullptr, 122, 121}; pg8::StaticOrder S; S.init(64, 8, G, (int)blockIdx.x);
          pg8::EpiGate<true, true> E{(bf16_t*)(ws + WS_MERGED), (const bf16_t*)(ws + WS_T1), (const bf16_t*)(ws + WS_GATES), 2048};
          pg8::gemm_phase<pg8::EpiGate<true, true>, pg8::StaticOrder, PG8_ALIGN, PG8_SP2, false, true>(lds, g, S, E); }
    } SEAM(5);
    if (IN(6)) {
        pg8::Gemm g{(const bf16_t*)(ws + WS_MERGED), (const bf16_t*)(ws + WS_WOUTT), 1024, 1024, 1024, nullptr, 122, 123}; pg8::StaticOrder S; S.init(64, 8, G, (int)blockIdx.x);
        pg8::EpiPlain E{(bf16_t*)(ws + WS_YX), DM};
        pg8::gemm_phase<pg8::EpiPlain, pg8::StaticOrder, PG8_ALIGN, PG8_SP2, false, true>(lds, g, S, E);
    } SEAM(6);
    if (IN(7)) { phase7(args, lds); } SEAM(7);
    if (IN(9)) {
        LAS int* cum = (LAS int*)(lds + MISC_OFF + 512); build_cum(args, cum);
        LAS int* rt = (LAS int*)(lds + MISC_OFF + 4096);
        pg8::GroupedOrder S{cum, 4, G, (int)blockIdx.x};
        { const int* RM = (const int*)(ws + WS_ROWMAP2); const unsigned* cnt = (const unsigned*)(ws + WS_CTL) + CW_CNT; pg8::Unit uu;
          const int tid = opaque_tid();
          for (int i = 0; i < 8; ++i) { if (!S.next(i, uu)) break; if (tid < 256) { const int e = uu.pb >> 2, pos = (uu.pm - cum[e]) * 256 + tid;
              const int tk = pos < (int)__hip_atomic_load(cnt + 64 * e, RLX_AGENT) ? RM[e * RM_CAP + pos] : -1; rt[i * 256 + tid] = tk < 0 ? 0 : (tk >> 1); } }
          __syncthreads(); }
        pg8::Gemm g{(const bf16_t*)(ws + WS_H2), (const bf16_t*)(ws + WS_WGU), 1024, 1024, 1024, rt, 122};
        pg8::EpiGU E{(bf16_t*)(ws + WS_ACT)};
        pg8::gemm_phase<pg8::EpiGU, pg8::GroupedOrder, PG8_ALIGN, PG8_SP2, true, true>(lds, g, S, E);
        { const int tot = cum[32] * 4; int nfull = tot % G; if (G - nfull < G / 2) nfull = 0;
          if ((int)blockIdx.x >= nfull) { __syncthreads(); moe_cvt<1>(args, lds, (int)blockIdx.x - nfull, G - nfull); __syncthreads(); } }
    } SEAM(9);
    if (IN(10)) {
        LAS int* cum = (LAS int*)(lds + MISC_OFF + 512); build_cum(args, cum);
        pg8::Gemm g{(const bf16_t*)(ws + WS_ACT), (const bf16_t*)(ws + WS_WD), 256, 256, 256, nullptr, 123}; pg8::GroupedOrder S{cum, 8, G, (int)blockIdx.x};
        LAS int* tkt = (LAS int*)(lds + pg8::STAGE_BYTES); LAS float* wt = (LAS float*)(lds + pg8::STAGE_BYTES + pg8::EpiDown::DOWN_TAB * 1024);
        { const int* RM = (const int*)(ws + WS_ROWMAP2); const unsigned* cnt = (const unsigned*)(ws + WS_CTL) + CW_CNT; const float* TWf = (const float*)(ws + WS_TW); pg8::Unit uu;
          const int tid = opaque_tid();
          for (int i = 0; i < pg8::EpiDown::DOWN_TAB; ++i) { if (!S.next(i, uu)) break;
              if (tid < 256) { const int e = uu.pb >> 3, pos = (uu.pm - cum[e]) * 256 + tid;
                  const int tk = pos < (int)__hip_atomic_load(cnt + 64 * e, RLX_AGENT) ? RM[e * RM_CAP + pos] : -1; tkt[i * 256 + tid] = tk; wt[i * 256 + tid] = tk < 0 ? 0.f : TWf[tk]; } }
          __syncthreads(); }
        pg8::EpiDown E{(bf16_t*)(ws + WS_Y2), tkt, wt};
        pg8::gemm_phase<pg8::EpiDown, pg8::GroupedOrder, PG8_ALIGN, PG8_SP2, false, true>(lds, g, S, E);
    } SEAM(10);
    if (IN(11)) { phase11(args); }
#undef IN
#undef SEAM
}

extern "C" void kernel_launch(void* const* d_in, const int* in_sizes, int n_in, void* d_out, int out_size, void* d_ws, size_t ws_size, hipStream_t stream) {
    static int grid = 0;
    if (grid == 0) {
        if (n_in != 27 || in_sizes[0] != T * DM || out_size != T * DM || ws_size < WS_END) {
            fprintf(stderr, "kernel_launch: built for 27 inputs, x/out of %d floats, >= %zu bytes of workspace; got n_in %d, in0 %d, out %d, ws %zu; nothing launched\n", T * DM, (size_t)WS_END, n_in, n_in > 0 ? in_sizes[0] : -1, out_size, ws_size);
            grid = -1; return; }
        int dev = 0, cus = 0, per_cu = 0;
        if (hipGetDevice(&dev) != hipSuccess || hipDeviceGetAttribute(&cus, hipDeviceAttributeMultiprocessorCount, dev) != hipSuccess) { fprintf(stderr, "kernel_launch: device query failed\n"); grid = -1; return; }
        if (hipFuncSetAttribute((const void*)fwd, hipFuncAttributeMaxDynamicSharedMemorySize, LDS_BYTES) != hipSuccess) { fprintf(stderr, "kernel_launch: hipFuncSetAttribute failed\n"); grid = -1; return; }
        if (hipOccupancyMaxActiveBlocksPerMultiprocessor(&per_cu, (const void*)fwd, 512, LDS_BYTES) != hipSuccess || per_cu < 1)
            fprintf(stderr, "kernel_launch: note: occupancy query reports %d workgroups per CU\n", per_cu);
        (void)hipGetLastError();
        grid = cus;
    }
    if (grid < 0) return;
    if (hipMemsetAsync((char*)d_ws + WS_CTL, 0, CTL_ZERO_BYTES, stream) != hipSuccess) { fprintf(stderr, "kernel_launch: memset failed\n"); return; }
    Args a{};
    for (int i = 0; i < 27; ++i) a.in[i] = (const float*)d_in[i];
    a.out = (float*)d_out; a.ws = (unsigned char*)d_ws;
#if MK_PER_PHASE
    for (int p = 0; p < NPHASE; ++p) { a.ph_lo = p; a.ph_hi = p + 1; hipLaunchKernelGGL(fwd, dim3(grid), dim3(512), LDS_BYTES, stream, a); }
#else
    a.ph_lo = 0; a.ph_hi = NPHASE; hipLaunchKernelGGL(fwd, dim3(grid), dim3(512), LDS_BYTES, stream, a);
#endif
    const hipError_t le = hipPeekAtLastError();
    if (le != hipSuccess) fprintf(stderr, "kernel_launch: launch failed: %s\n", hipGetErrorName(le));
}
```
